# Optimizing an MI355X kernel written in HIP

```python
import math
import jax, jax.numpy as jnp
from jax import lax
import numpy as np

D_MODEL = 1024
BATCH = 2
SEQ = 16384
DEPTH = 4

N_GROUPS_A = 4
GROUP_DIM_A = 64
W_A = N_GROUPS_A * GROUP_DIM_A
CONV_WIDTH = 3
N_HEADS_B = 4
HEAD_DIM_B = 64
W_B = N_HEADS_B * HEAD_DIM_B
Q_BLOCK = 128
K_BLOCK = 128
N_GROUPS_C = 4
GROUP_DIM_C = 64
W_C = N_GROUPS_C * GROUP_DIM_C
CHUNK = 128
N_BRANCH = 3
BRANCH_W = W_A
SPLIT_SIZES = (W_A, W_A, W_A, W_B, W_B, W_B, W_C, W_C, N_BRANCH * D_MODEL)
IN_COLS = 3 * W_A + 3 * W_B + 2 * W_C + N_BRANCH * D_MODEL
N_EXPERTS = 16
N_EXPERT_GROUPS = 4
EXPERTS_PER_GROUP = N_EXPERTS // N_EXPERT_GROUPS
TOP_K = 2
D_FF_EXPERT = 128
DEEPNORM_ALPHA = (2 * DEPTH) ** 0.25
DEEPNORM_BETA = (8 * DEPTH) ** -0.25
LN_EPS = 1e-5

kernel_name = "hybrid_conv_stickbreak_gmlp_grouped_moe_deepnorm"


def layer_norm(x, g, b):
    xf = x.astype(jnp.float32)
    mu = jnp.mean(xf, axis=-1, keepdims=True)
    var = jnp.mean(jnp.square(xf - mu), axis=-1, keepdims=True)
    y = (xf - mu) * lax.rsqrt(var + LN_EPS) * g.astype(jnp.float32) + b.astype(jnp.float32)
    return y.astype(x.dtype)


def short_conv_mixer(h, bg, cg, conv_w):
    u = cg * h
    y = lax.conv_general_dilated(
        u, conv_w[:, None, :], window_strides=(1,),
        padding=[(CONV_WIDTH - 1, 0)],
        dimension_numbers=("NWC", "WIO", "NWC"),
        feature_group_count=W_A)
    return bg * y


def stick_breaking_attention(q, k, v):
    b, s, h, dh = q.shape
    nb = s // Q_BLOCK
    scale = dh ** -0.5
    tri_in = (jnp.arange(K_BLOCK)[:, None] > jnp.arange(K_BLOCK)[None, :]).astype(jnp.float32)
    outs = []
    for i in range(nb):
        kv_len = (i + 1) * Q_BLOCK
        nk = kv_len // K_BLOCK
        q_blk = q[:, i * Q_BLOCK:(i + 1) * Q_BLOCK]
        z = jnp.einsum("bqhd,bkhd->bhqk", q_blk, k[:, :kv_len],
                       preferred_element_type=jnp.float32) * scale
        q_pos = i * Q_BLOCK + jnp.arange(Q_BLOCK)
        strict = jnp.arange(kv_len)[None, :] < q_pos[:, None]
        log_not = jnp.where(strict, -jax.nn.softplus(z), 0.0)
        ln_blk = log_not.reshape(b, h, Q_BLOCK, nk, K_BLOCK)
        within = jnp.einsum("bhqmj,js->bhqms", ln_blk, tri_in)
        tri_blk = (jnp.arange(nk)[:, None] > jnp.arange(nk)[None, :]).astype(jnp.float32)
        blk_after = jnp.einsum("bhqn,nm->bhqm", ln_blk.sum(-1), tri_blk)
        after = (within + blk_after[..., None]).reshape(b, h, Q_BLOCK, kv_len)
        a = jnp.where(strict, jnp.exp(jax.nn.log_sigmoid(z) + after), 0.0)
        outs.append(jnp.einsum("bhqk,bkhd->bqhd", a.astype(v.dtype), v[:, :kv_len]))
    out = jnp.concatenate(outs, axis=1)
    return out.reshape(b, s, h * dh)


def spatial_gating_mixer(u, v, w_s, b_s, ln_g, ln_b):
    b, s, _ = u.shape
    v = layer_norm(v, ln_g, ln_b)
    vc = v.reshape(b, s // CHUNK, CHUNK, N_GROUPS_C, GROUP_DIM_C)
    w = w_s * jnp.tril(jnp.ones((CHUNK, CHUNK), w_s.dtype))
    f = jnp.einsum("gts,bnsgc->bntgc", w, vc) + b_s.T[None, None, :, :, None]
    return u * f.reshape(b, s, W_C)


def hybrid_mixer(x, w_in, b_gate, conv_w, sg_w, sg_b, sg_ln_g, sg_ln_b, w_br, w_o):
    b, s, d = x.shape
    proj = x @ w_in
    offsets = np.cumsum(SPLIT_SIZES)[:-1].tolist()
    h_a, bg_a, cg_a, q, k, v, u_c, v_c, gate_logits = jnp.split(proj, offsets, axis=-1)
    y_a = short_conv_mixer(h_a, bg_a, cg_a, conv_w)
    y_b = stick_breaking_attention(q.reshape(b, s, N_HEADS_B, HEAD_DIM_B),
                                   k.reshape(b, s, N_HEADS_B, HEAD_DIM_B),
                                   v.reshape(b, s, N_HEADS_B, HEAD_DIM_B))
    y_c = spatial_gating_mixer(jax.nn.gelu(u_c), jax.nn.gelu(v_c), sg_w, sg_b, sg_ln_g, sg_ln_b)
    gates = jax.nn.sigmoid(gate_logits.reshape(b, s, N_BRANCH, d) + b_gate)
    branches = (y_a, y_b, y_c)
    merged = gates[:, :, 0] * (branches[0] @ w_br[0])
    for i in range(1, N_BRANCH):
        merged = merged + gates[:, :, i] * (branches[i] @ w_br[i])
    return merged @ w_o


def moe_ffn(x, w_router, router_bias, w_gate, w_up, w_down):
    b, s, d = x.shape
    xt = x.reshape(-1, d)
    n_tok = xt.shape[0]
    scores = jax.nn.sigmoid((xt @ w_router).astype(jnp.float32))
    sel = scores + router_bias.astype(jnp.float32)
    sel_g = sel.reshape(n_tok, N_EXPERT_GROUPS, EXPERTS_PER_GROUP)
    group_score = lax.top_k(sel_g, TOP_K)[0].sum(-1)
    best_group = jnp.argmax(group_score, axis=-1)
    group_mask = jax.nn.one_hot(best_group, N_EXPERT_GROUPS, dtype=jnp.bool_)
    masked_sel = jnp.where(group_mask[:, :, None], sel_g, -jnp.inf).reshape(n_tok, N_EXPERTS)
    _, top_idx = lax.top_k(masked_sel, TOP_K)
    top_s = jnp.take_along_axis(scores, top_idx, axis=-1)
    top_w = top_s / jnp.sum(top_s, axis=-1, keepdims=True)
    dense_w = jnp.sum(jax.nn.one_hot(top_idx, N_EXPERTS, dtype=jnp.float32) * top_w[..., None], axis=1)
    dense_w = dense_w.astype(xt.dtype)
    hidden = jax.nn.silu(jnp.einsum("td,edf->tef", xt, w_gate)) * jnp.einsum("td,edf->tef", xt, w_up)
    y = jnp.einsum("tef,efd->td", hidden * dense_w[:, :, None], w_down)
    return y.reshape(b, s, d)


def setup_inputs(seed: int = 0) -> dict:
    key = jax.random.key(seed)
    ks = jax.random.split(key, 24)
    f32 = jnp.float32
    nrm = lambda k, shape, sc: jax.random.normal(k, shape, f32) * sc
    return {
        "x": nrm(ks[0], (BATCH, SEQ, D_MODEL), 1.0),
        "ln_in_g": 1.0 + nrm(ks[1], (D_MODEL,), 0.05),
        "ln_in_b": nrm(ks[2], (D_MODEL,), 0.02),
        "w_in": nrm(ks[3], (DEPTH, D_MODEL, IN_COLS), D_MODEL ** -0.5),
        "b_gate": nrm(ks[4], (DEPTH, N_BRANCH, D_MODEL), 0.1),
        "conv_w": nrm(ks[5], (DEPTH, CONV_WIDTH, W_A), CONV_WIDTH ** -0.5),
        "sg_w": nrm(ks[6], (DEPTH, N_GROUPS_C, CHUNK, CHUNK), CHUNK ** -0.5),
        "sg_b": 1.0 + nrm(ks[7], (DEPTH, N_GROUPS_C, CHUNK), 0.1),
        "sg_ln_g": 1.0 + nrm(ks[8], (DEPTH, W_C), 0.05),
        "sg_ln_b": nrm(ks[9], (DEPTH, W_C), 0.02),
        "w_br": nrm(ks[10], (DEPTH, N_BRANCH, BRANCH_W, D_MODEL), (BRANCH_W ** -0.5) * DEEPNORM_BETA),
        "w_o": nrm(ks[11], (DEPTH, D_MODEL, D_MODEL), (D_MODEL ** -0.5) * DEEPNORM_BETA),
        "ln_mix_g": 1.0 + nrm(ks[12], (DEPTH, D_MODEL), 0.05),
        "ln_mix_b": nrm(ks[13], (DEPTH, D_MODEL), 0.02),
        "w_router": nrm(ks[14], (D_MODEL, N_EXPERTS), D_MODEL ** -0.5),
        "router_bias": nrm(ks[15], (N_EXPERTS,), 0.01),
        "w_gate": nrm(ks[16], (DEPTH, N_EXPERTS, D_MODEL, D_FF_EXPERT), D_MODEL ** -0.5),
        "w_up": nrm(ks[17], (DEPTH, N_EXPERTS, D_MODEL, D_FF_EXPERT), D_MODEL ** -0.5),
        "w_down": nrm(ks[18], (DEPTH, N_EXPERTS, D_FF_EXPERT, D_MODEL), (D_FF_EXPERT ** -0.5) * DEEPNORM_BETA),
        "ln_ffn_g": 1.0 + nrm(ks[19], (DEPTH, D_MODEL), 0.05),
        "ln_ffn_b": nrm(ks[20], (DEPTH, D_MODEL), 0.02),
    }


def reference(x, ln_in_g, ln_in_b, w_in, b_gate, conv_w, sg_w, sg_b, sg_ln_g, sg_ln_b,
              w_br, w_o, ln_mix_g, ln_mix_b, w_router, router_bias, w_gate, w_up, w_down,
              ln_ffn_g, ln_ffn_b):
    h = layer_norm(x, ln_in_g, ln_in_b)
    for l in range(DEPTH):
        mix = hybrid_mixer(h, w_in[l], b_gate[l], conv_w[l], sg_w[l], sg_b[l],
                           sg_ln_g[l], sg_ln_b[l], w_br[l], w_o[l])
        h = layer_norm(DEEPNORM_ALPHA * h + mix, ln_mix_g[l], ln_mix_b[l])
        ffn = moe_ffn(h, w_router, router_bias, w_gate[l], w_up[l], w_down[l])
        h = layer_norm(DEEPNORM_ALPHA * h + ffn, ln_ffn_g[l], ln_ffn_b[l])
    return h
```

```cpp
#include <hip/hip_runtime.h>
#include <cstdio>
#include <cstdint>

#ifndef MK_PER_PHASE
#define MK_PER_PHASE 1
#endif

#define GAS __attribute__((address_space(1)))
#define LAS __attribute__((address_space(3)))
typedef unsigned short bf16;
typedef short bf16x8 __attribute__((ext_vector_type(8)));
typedef float f32x4 __attribute__((ext_vector_type(4)));
typedef float f32x2 __attribute__((ext_vector_type(2)));
typedef float f32x16 __attribute__((ext_vector_type(16)));
typedef unsigned u32x4 __attribute__((ext_vector_type(4)));
typedef unsigned u32x2 __attribute__((ext_vector_type(2)));
typedef GAS unsigned gu32;

constexpr int DM = 1024, BATCH = 2, SEQ = 16384, T = BATCH * SEQ, DEPTH = 4, INC = 5120;
constexpr float ALPHA = 1.6817928305074292f;
constexpr float LN_EPS = 1e-5f;
constexpr int NWAVES = 8, NTHREADS = 512;
constexpr int NPH = 1 + 8 * DEPTH;

constexpr size_t MiB = 1u << 20;
constexpr size_t WS_CTL = 0, CTL_ZERO_BYTES = 1 * MiB;
constexpr size_t WS_WIN = 1 * MiB;
constexpr size_t WS_WBR = 11 * MiB;
constexpr size_t WS_WO = 13 * MiB;
constexpr size_t WS_WGU = 15 * MiB;
constexpr size_t WS_WD = 23 * MiB;
constexpr size_t WS_SGW = 27 * MiB;
constexpr size_t WS_PERM = 28 * MiB;
constexpr size_t WS_DWP = 29 * MiB;
constexpr size_t WS_HB = 32 * MiB;
constexpr size_t WS_PA = 96 * MiB;
constexpr size_t WS_Q = 144 * MiB;
constexpr size_t WS_K = 160 * MiB;
constexpr size_t WS_VT = 176 * MiB;
constexpr size_t WS_UC = 192 * MiB;
constexpr size_t WS_GATE = 224 * MiB;
constexpr size_t WS_Y = 416 * MiB;
constexpr size_t WS_END = 464 * MiB;

constexpr int CW_TMO = 0, CW_CODE = 1, CW_BAR = 4096, CW_CNT = 8192;

constexpr int RING_BYTES = 131072, ROWTAB_OFF = RING_BYTES, ROWTAB_BYTES = 8192, LDSCTL_OFF = ROWTAB_OFF + ROWTAB_BYTES, MISC_OFF = LDSCTL_OFF + 320;
constexpr int LDS_BYTES = 147456;

__device__ __forceinline__ unsigned cvt_pk_bf16(float lo, float hi) { unsigned r; asm volatile("v_cvt_pk_bf16_f32 %0, %1, %2" : "=v"(r) : "v"(lo), "v"(hi)); return r; }
__device__ __forceinline__ float bf_lo(unsigned u) { return __uint_as_float(u << 16); }
__device__ __forceinline__ float bf_hi(unsigned u) { return __uint_as_float(u & 0xffff0000u); }
__device__ __forceinline__ float shfl_xor_l(float v, int mask, int lane) { return __int_as_float(__builtin_amdgcn_ds_bpermute((lane ^ mask) << 2, __float_as_int(v))); }
__device__ __forceinline__ float wave_sum(float v, int lane) {
#pragma unroll
    for (int o = 1; o < 64; o <<= 1) v += shfl_xor_l(v, o, lane);
    return v;
}
__device__ __forceinline__ float sigmoid_fast(float x) { return __builtin_amdgcn_rcpf(1.f + __builtin_amdgcn_exp2f(-1.4426950409f * x)); }
__device__ __forceinline__ float gelu_tanh(float x) { const float u = x * (1.f + 0.044715f * x * x); return x * __builtin_amdgcn_rcpf(1.f + __builtin_amdgcn_exp2f(-2.302208198f * u)); }
#define LDS_WAIT() asm volatile("s_waitcnt lgkmcnt(0)" ::: "memory")
#define VM_WAIT() asm volatile("s_waitcnt vmcnt(0)" ::: "memory")
#define RLX_AGENT __ATOMIC_RELAXED, __HIP_MEMORY_SCOPE_AGENT

__device__ __forceinline__ int opq(int v) { asm volatile("" : "+v"(v)); return v; }
__device__ __forceinline__ int opqs(int v) { asm volatile("" : "+s"(v)); return v; }
__device__ __forceinline__ int cur_lane() { int l; asm volatile("v_mbcnt_lo_u32_b32 %0, -1, 0\n\tv_mbcnt_hi_u32_b32 %0, -1, %0" : "=v"(l)); return l; }
namespace pg8 {
#define PG8_LAS __attribute__((address_space(3)))
typedef unsigned short bf16_t;
constexpr int BM = 256, BK = 64, HALF = 128, HTB = HALF * BK * 2, STAGE_BYTES = 8 * HTB, NXCD = 8, WGM = 8, MAXU = 8;

__host__ __device__ __forceinline__ int lds_byte(int r, int c) { const int st = (r >> 4) * 2 + (c >> 5), rr = r & 15, cc = c & 31, ob = rr * 64 + cc * 2; return st * 1024 + (ob ^ (((ob >> 9) & 1) << 5)); }
__host__ __device__ __forceinline__ void stage_rc(int b, int& R, int& C) { const int st = b / 1024, sb = b % 1024, swz = sb ^ (((sb >> 9) & 1) << 5); R = (st >> 1) * 16 + swz / 64; C = (st & 1) * 32 + (swz % 64) / 2; }
__host__ __device__ __forceinline__ int perm32(int rho) { const int n = rho >> 4, i = rho & 15; return 8 * (i >> 2) + 4 * n + (i & 3); }

struct Unit { int pm, pn; };
struct Gemm { const bf16_t* A; const bf16_t* Bt; int M, N, K; };

struct StaticOrder {
    int nM, nN, nwg, G, c;
    __host__ __device__ void init(int M, int N, int G_, int c_) { nM = M / BM; nN = N / BM; nwg = nM * nN; G = G_; c = c_; }
    __host__ __device__ bool next(int i, Unit& u) const {
        const long L = (long)i * G + c; if (L >= nwg) return false;
        int wgid = (int)L; { const int q = nwg / NXCD, r = nwg % NXCD, xcd = wgid % NXCD, off = wgid / NXCD; wgid = (xcd < r ? xcd * (q + 1) : r * (q + 1) + (xcd - r) * q) + off; }
        const int nig = WGM * nN, gid = wgid / nig, fm = gid * WGM, gsz = (nM - fm) < WGM ? (nM - fm) : WGM;
        u.pm = fm + ((wgid % nig) % gsz); u.pn = (wgid % nig) / gsz; return true;
    }
    __device__ __forceinline__ int arow(const Unit&, int) const { return 0; }
    __device__ __forceinline__ void a_ready(const Unit&) const {}
    __device__ __forceinline__ void done(const Unit&) const {}
};

template <class Epi, class Sched, bool ALIGN_EPI, bool GATHER>
__device__ __forceinline__ void gemm_phase(PG8_LAS unsigned char* lds, const int wid, const Gemm g, const Sched& S, const Epi& E) {
    const int lane = cur_lane(), tid = wid * 64 + lane, wr = wid >> 2, wc = wid & 3, fr = lane & 15, fq = lane >> 4;
    const int K = g.K, nt = K / BK;
    unsigned voffA[2], voffB[2]; int Rr[2], Cc[2];
#pragma unroll
    for (int i = 0; i < 2; ++i) { int R, C; stage_rc(tid * 16 + i * 8192, R, C); const int Rb = Epi::PERM ? ((R & ~31) + perm32(R & 31)) : R;
        Rr[i] = R; Cc[i] = C; voffA[i] = (unsigned)(R * K + C) * 2u; voffB[i] = (unsigned)(Rb * K + C) * 2u; }
    const size_t kstep = (size_t)(BK * 2);
    const size_t hstep = (size_t)HALF * K * 2;
    const size_t tstep = 2 * hstep;
    const unsigned ldsw = (unsigned)wid * 1024u;
    const int aoff = lds_byte(wr * 64 + fr, fq * 8), boff = lds_byte(wc * 32 + fr, fq * 8);
#define PG8_SA(b, h) (((b) * 2 + (h)) * HTB)
#define PG8_SB(b, h) ((4 + (b) * 2 + (h)) * HTB)
#define PG8_STAGE(bufoff, gbase, voff) do { _Pragma("unroll") for (int _i = 0; _i < 2; ++_i) \
        __builtin_amdgcn_global_load_lds((const unsigned*)((const char*)(gbase) + (voff)[_i]), (PG8_LAS unsigned*)(lds + (bufoff) + ldsw + _i * 8192), 16, 0, 0); } while (0)
#define PG8_STAGE_A(bufoff, kp, h, vs) do { if constexpr (GATHER) { PG8_STAGE(bufoff, kp, vs[h]); } else { PG8_STAGE(bufoff, (kp) + (h) * hstep, voffA); } } while (0)
#define PG8_LDA(dst, b, h) do { _Pragma("unroll") for (int m = 0; m < 4; ++m) _Pragma("unroll") for (int k = 0; k < 2; ++k) dst[m][k] = *(const PG8_LAS bf16x8*)(lds + PG8_SA(b, h) + aoff + m * 2048 + k * 1024); } while (0)
#define PG8_LDB(dst, b, h) do { _Pragma("unroll") for (int n = 0; n < 2; ++n) _Pragma("unroll") for (int k = 0; k < 2; ++k) dst[n][k] = *(const PG8_LAS bf16x8*)(lds + PG8_SB(b, h) + boff + n * 2048 + k * 1024); } while (0)
#define PG8_MMA(ai, bj, At, Bt) do { __builtin_amdgcn_s_setprio(1); _Pragma("unroll") for (int m = 0; m < 4; ++m) _Pragma("unroll") for (int n = 0; n < 2; ++n) _Pragma("unroll") for (int k = 0; k < 2; ++k) \
        acc[ai][bj][m][n] = __builtin_amdgcn_mfma_f32_16x16x32_bf16(Bt[n][k], At[m][k], acc[ai][bj][m][n], 0, 0, 0); __builtin_amdgcn_s_setprio(0); } while (0)
#define PG8_WAIT_V(n) asm volatile("s_waitcnt vmcnt(" #n ")" ::: "memory")
#define PG8_WAIT_L(n) asm volatile("s_waitcnt lgkmcnt(" #n ")" ::: "memory")
#define PG8_BAR __builtin_amdgcn_s_barrier()
#define PG8_SCHED __builtin_amdgcn_sched_barrier(0)
    Unit cur, nxt; int ui = 0;
    if (!S.next(0, cur)) return;
    PG8_LAS int* rowtab = (PG8_LAS int*)(lds + STAGE_BYTES);
    unsigned vAc[2][2], vAn[2][2], vS[2][2];
    if constexpr (GATHER) {
        Unit uu;
        for (int i = 0; i < MAXU; ++i) { if (!S.next(i, uu)) break; if (tid < 256) rowtab[i * 256 + tid] = S.arow(uu, tid); }
        asm volatile("s_waitcnt vmcnt(0) lgkmcnt(0)" ::: "memory"); __builtin_amdgcn_s_barrier(); asm volatile("" ::: "memory");
#pragma unroll
        for (int h = 0; h < 2; ++h)
#pragma unroll
            for (int i = 0; i < 2; ++i) { vAc[h][i] = (unsigned)(rowtab[h * 128 + Rr[i]] * K + Cc[i]) * 2u; vAn[h][i] = vAc[h][i]; vS[h][i] = vAc[h][i]; }
    }
    f32x4 acc[2][2][4][2];
#pragma unroll
    for (int a = 0; a < 2; ++a)
#pragma unroll
        for (int b = 0; b < 2; ++b)
#pragma unroll
            for (int m = 0; m < 4; ++m)
#pragma unroll
                for (int n = 0; n < 2; ++n) acc[a][b][m][n] = (f32x4){0.f, 0.f, 0.f, 0.f};
    bf16x8 At[4][2], B0[2][2], B1[2][2];
    const char* cA = GATHER ? (const char*)g.A : (const char*)g.A + (size_t)cur.pm * tstep; const char* cB = (const char*)g.Bt + (size_t)cur.pn * tstep;
    S.a_ready(cur);
    PG8_STAGE(PG8_SB(0, 0), cB, voffB); PG8_STAGE(PG8_SB(0, 1), cB + hstep, voffB); PG8_STAGE_A(PG8_SA(0, 0), cA, 0, vAc); PG8_STAGE_A(PG8_SA(0, 1), cA, 1, vAc);
    if (wr == 1) PG8_BAR;
    PG8_WAIT_V(2); PG8_BAR;
    PG8_STAGE(PG8_SB(1, 0), cB + kstep, voffB); PG8_STAGE_A(PG8_SA(1, 0), cA + kstep, 0, vAc); PG8_STAGE(PG8_SB(1, 1), cB + hstep + kstep, voffB);
    PG8_WAIT_V(6); PG8_BAR;
    for (;;) {
        const bool has_next = S.next(ui + 1, nxt);
        const char* nA = GATHER ? cA : (has_next ? (const char*)g.A + (size_t)nxt.pm * tstep : cA); const char* nB = has_next ? (const char*)g.Bt + (size_t)nxt.pn * tstep : cB;
        if constexpr (GATHER) {
            if (has_next) {
#pragma unroll
                for (int h = 0; h < 2; ++h)
#pragma unroll
                    for (int i = 0; i < 2; ++i) vAn[h][i] = (unsigned)(rowtab[(ui + 1) * 256 + h * 128 + Rr[i]] * K + Cc[i]) * 2u;
            }
        }
        for (int t = 0; t < nt; t += 2) {
            const bool last = (t == nt - 2);
            const char* a1 = cA + (size_t)(t + 1) * kstep;
            const char* a2 = last ? nA : cA + (size_t)(t + 2) * kstep; const char* b2 = last ? nB : cB + (size_t)(t + 2) * kstep;
            const char* a3 = a2 + kstep; const char* b3 = b2 + kstep;
            if constexpr (GATHER) {
#pragma unroll
                for (int h = 0; h < 2; ++h)
#pragma unroll
                    for (int i = 0; i < 2; ++i) vS[h][i] = last ? vAn[h][i] : vAc[h][i];
            }
            if (last && has_next) S.a_ready(nxt);
            PG8_LDB(B0, 0, 0); PG8_LDB(B1, 0, 1); PG8_SCHED; PG8_LDA(At, 0, 0); PG8_STAGE_A(PG8_SA(1, 1), a1, 1, vAc);
            PG8_WAIT_V(8); PG8_WAIT_L(0); PG8_BAR; PG8_MMA(0, 0, At, B0); PG8_MMA(0, 1, At, B1); PG8_BAR; PG8_SCHED;
            PG8_LDA(At, 0, 1); PG8_STAGE(PG8_SB(0, 0), b2, voffB); PG8_STAGE(PG8_SB(0, 1), b2 + hstep, voffB); PG8_STAGE_A(PG8_SA(0, 0), a2, 0, vS);
            PG8_WAIT_V(8); PG8_WAIT_L(0); PG8_BAR; PG8_MMA(1, 0, At, B0); PG8_MMA(1, 1, At, B1); PG8_BAR; PG8_SCHED;
            PG8_LDB(B0, 1, 0); PG8_LDB(B1, 1, 1); PG8_SCHED; PG8_LDA(At, 1, 0); PG8_STAGE_A(PG8_SA(0, 1), a2, 1, vS);
            PG8_WAIT_V(8); PG8_WAIT_L(0); PG8_BAR; PG8_MMA(0, 0, At, B0); PG8_MMA(0, 1, At, B1); PG8_BAR; PG8_SCHED;
            PG8_LDA(At, 1, 1); PG8_STAGE(PG8_SB(1, 0), b3, voffB); PG8_STAGE(PG8_SB(1, 1), b3 + hstep, voffB); PG8_STAGE_A(PG8_SA(1, 0), a3, 0, vS);
            PG8_WAIT_V(8); PG8_WAIT_L(0); PG8_BAR; PG8_MMA(1, 0, At, B0); PG8_MMA(1, 1, At, B1); PG8_BAR; PG8_SCHED;
        }
        if constexpr (ALIGN_EPI) { if (wr == 0) PG8_BAR; }
        E(acc, cur, wr, wc, fr, fq); S.done(cur);
        if (!has_next) break;
#pragma unroll
        for (int a = 0; a < 2; ++a)
#pragma unroll
            for (int b = 0; b < 2; ++b)
#pragma unroll
                for (int m = 0; m < 4; ++m)
#pragma unroll
                    for (int n = 0; n < 2; ++n) acc[a][b][m][n] = (f32x4){0.f, 0.f, 0.f, 0.f};
        cur = nxt; cA = nA; cB = nB; ++ui;
        if constexpr (GATHER) {
#pragma unroll
            for (int h = 0; h < 2; ++h)
#pragma unroll
                for (int i = 0; i < 2; ++i) vAc[h][i] = vAn[h][i];
        }
        if constexpr (ALIGN_EPI) { if (wr == 1) PG8_BAR; }
    }
    PG8_WAIT_V(0);
    if constexpr (!ALIGN_EPI) { if (wr == 0) PG8_BAR; }
    PG8_BAR;
#undef PG8_SA
#undef PG8_SB
#undef PG8_STAGE
#undef PG8_STAGE_A
#undef PG8_LDA
#undef PG8_LDB
#undef PG8_MMA
#undef PG8_WAIT_V
#undef PG8_WAIT_L
#undef PG8_BAR
#undef PG8_SCHED
}
}

#define XB_TMO      128
#define XB_XCNT(j)  (256  + 64 * (j))
#define XB_XSUB(j)  (1280 + 64 * (j))
#define XB_XGEN(j)  (2304 + 64 * (j))
#define XB_TOP      3328
#define XB_TOPGEN   3392
#define XCD_BAR_WORDS 3456
#define XB_SPIN_CAP (1u << 18)

__device__ __forceinline__ unsigned xb_ld(unsigned* p)              { return __hip_atomic_load(p, __ATOMIC_RELAXED, __HIP_MEMORY_SCOPE_AGENT); }
__device__ __forceinline__ unsigned xb_add(unsigned* p, unsigned v) { return __hip_atomic_fetch_add(p, v, __ATOMIC_RELAXED, __HIP_MEMORY_SCOPE_AGENT); }
__device__ __forceinline__ unsigned xb_xcc_id() { return (unsigned)__builtin_amdgcn_s_getreg((3 << 11) | 20) & 0xFu; }
#define XB_SPIN(cond, bar) do { unsigned _sp = 0; while (cond) { __builtin_amdgcn_s_sleep(1); \
    if ((++_sp & 255u) == 0u) { if (xb_ld(&(bar)[XB_TMO])) break; if (_sp > XB_SPIN_CAP) { atomicAdd(&(bar)[XB_TMO], 1u); break; } } } } while (0)

struct XcdBarrier {
    unsigned* bar; unsigned x;
    volatile LAS unsigned* st;
};
__device__ __forceinline__ XcdBarrier xcd_barrier_post(unsigned* bar, volatile LAS unsigned* st) {
    XcdBarrier b; b.bar = bar; b.x = xb_xcc_id(); b.st = st;
    if (threadIdx.x == 0) (void)xb_add(&bar[XB_XCNT(b.x)], 1u);
    return b;
}
__device__ __forceinline__ void xcd_barrier_complete(unsigned* bar, unsigned x, unsigned& nloc, unsigned& nx) {
    const unsigned G = gridDim.x * gridDim.y * gridDim.z;
    unsigned sum, cnt, mine, sp = 0u;
    for (;;) {
        sum = 0u; cnt = 0u; mine = 0u;
#pragma unroll
        for (unsigned j = 0; j < 16; ++j) { const unsigned c = xb_ld(&bar[XB_XCNT(j)]); sum += c; cnt += (c > 0u) ? 1u : 0u; mine = (j == x) ? c : mine; }
        if (sum == G) break;
        __builtin_amdgcn_s_sleep(1);
        if ((++sp & 255u) == 0u) { if (xb_ld(&bar[XB_TMO])) break; if (sp > XB_SPIN_CAP) { atomicAdd(&bar[XB_TMO], 1u); break; } }
    }
    nloc = mine > 0u ? mine : 1u; nx = cnt > 0u ? cnt : 1u;
}
__device__ __forceinline__ void xcd_barrier(const XcdBarrier& b, const bool thread0) {
    asm volatile("s_waitcnt vmcnt(0)" ::: "memory");
    __syncthreads();
    if (thread0) {
        unsigned* bar = b.bar;
        __builtin_amdgcn_s_waitcnt(0);
        unsigned nloc = b.st[0], nx = b.st[1];
        if (nloc == 0u) { xcd_barrier_complete(bar, b.x, nloc, nx); b.st[0] = nloc; b.st[1] = nx; }
        const unsigned old = xb_add(&bar[XB_XSUB(b.x)], 1u);
        const unsigned gen = old / nloc;
        if (old + 1u == (gen + 1u) * nloc) {
            __builtin_amdgcn_fence(__ATOMIC_RELEASE, "agent");
            asm volatile("s_waitcnt vmcnt(0)" ::: "memory");
            const unsigned og = xb_add(&bar[XB_TOP], 1u);
            const unsigned tg = og / nx;
            if (og + 1u == (tg + 1u) * nx) xb_add(&bar[XB_TOPGEN], 1u);
            else XB_SPIN(xb_ld(&bar[XB_TOPGEN]) == tg, bar);
            __builtin_amdgcn_fence(__ATOMIC_ACQUIRE, "agent");
            xb_add(&bar[XB_XGEN(b.x)], 1u);
            asm volatile("s_waitcnt vmcnt(0)" ::: "memory");
        } else {
            XB_SPIN(xb_ld(&bar[XB_XGEN(b.x)]) == gen, bar);
            __builtin_amdgcn_fence(__ATOMIC_ACQUIRE, "agent");
            asm volatile("s_waitcnt vmcnt(0)" ::: "memory");
        }
    }
    __syncthreads();
}

using pg8::Unit;
struct EpiProj {
    static constexpr bool PERM = true;
    bf16 *PA, *Q, *Kb, *UC, *GATE; const float* bgate;
    __device__ __forceinline__ void operator()(const f32x4 (&acc)[2][2][4][2], const Unit& u, int wr, int wc, int fr, int fq) const {
        const int pn = u.pn; bf16* dst; int ldc, cb, act;
        if (pn < 3) { dst = PA; ldc = 768; cb = pn * 256; act = 0; }
        else if (pn == 3) { dst = Q; ldc = 256; cb = 0; act = 3; }
        else if (pn == 4) { dst = Kb; ldc = 256; cb = 0; act = 0; }
        else if (pn < 8) { dst = UC; ldc = 512; cb = (pn - 6) * 256; act = 1; }
        else { dst = GATE; ldc = 3072; cb = (pn - 8) * 256; act = 2; }
        const int row0 = u.pm * 256 + wr * 64 + fr, col0 = cb + wc * 32 + 8 * fq;
        f32x4 bv[2][2];
#pragma unroll
        for (int bj = 0; bj < 2; ++bj)
#pragma unroll
            for (int n = 0; n < 2; ++n) bv[bj][n] = (act == 2) ? *(const f32x4*)(bgate + col0 + bj * 128 + 4 * n) : (f32x4){0.f, 0.f, 0.f, 0.f};
#pragma unroll
        for (int ai = 0; ai < 2; ++ai)
#pragma unroll
            for (int m = 0; m < 4; ++m) { bf16* rowp = dst + (size_t)(row0 + ai * 128 + m * 16) * ldc + col0;
#pragma unroll
                for (int bj = 0; bj < 2; ++bj) { f32x4 v0 = acc[ai][bj][m][0], v1 = acc[ai][bj][m][1];
                    if (act == 1) {
#pragma unroll
                        for (int j = 0; j < 4; ++j) { v0[j] = gelu_tanh(v0[j]); v1[j] = gelu_tanh(v1[j]); }
                    } else if (act == 2) { v0 = v0 + bv[bj][0]; v1 = v1 + bv[bj][1];
#pragma unroll
                        for (int j = 0; j < 4; ++j) { v0[j] = sigmoid_fast(v0[j]); v1[j] = sigmoid_fast(v1[j]); }
                    } else if (act == 3) { v0 = v0 * 0.125f; v1 = v1 * 0.125f; }
                    u32x4 w; w.x = cvt_pk_bf16(v0[0], v0[1]); w.y = cvt_pk_bf16(v0[2], v0[3]); w.z = cvt_pk_bf16(v1[0], v1[1]); w.w = cvt_pk_bf16(v1[2], v1[3]);
                    *(u32x4*)(rowp + bj * 128) = w; } }
    }
};
struct EpiVt {
    static constexpr bool PERM = true;
    bf16* VT;
    __device__ __forceinline__ void operator()(const f32x4 (&acc)[2][2][4][2], const Unit& u, int wr, int wc, int fr, int fq) const {
        const int row0 = wr * 64 + fr, col0 = u.pn * 256 + wc * 32 + 8 * fq;
#pragma unroll
        for (int ai = 0; ai < 2; ++ai)
#pragma unroll
            for (int m = 0; m < 4; ++m) { bf16* rowp = VT + (size_t)(row0 + ai * 128 + m * 16) * T + col0;
#pragma unroll
                for (int bj = 0; bj < 2; ++bj) { const f32x4 v0 = acc[ai][bj][m][0], v1 = acc[ai][bj][m][1];
                    u32x4 w; w.x = cvt_pk_bf16(v0[0], v0[1]); w.y = cvt_pk_bf16(v0[2], v0[3]); w.z = cvt_pk_bf16(v1[0], v1[1]); w.w = cvt_pk_bf16(v1[2], v1[3]);
                    *(u32x4*)(rowp + bj * 128) = w; } }
    }
};
struct EpiMerge {
    static constexpr bool PERM = true;
    const bf16* GATE; bf16* MG;
    __device__ __forceinline__ void operator()(const f32x4 (&acc)[2][2][4][2], const Unit& u, int wr, int wc, int fr, int fq) const {
        const int br = u.pn >> 2, pm = u.pm - br * (T / 256), pn = u.pn & 3;
        const int row0 = pm * 256 + wr * 64 + fr, col0 = pn * 256 + wc * 32 + 8 * fq;
#pragma unroll
        for (int ai = 0; ai < 2; ++ai)
#pragma unroll
            for (int m = 0; m < 4; ++m) { const size_t row = (size_t)(row0 + ai * 128 + m * 16);
#pragma unroll
                for (int bj = 0; bj < 2; ++bj) { const f32x4 v0 = acc[ai][bj][m][0], v1 = acc[ai][bj][m][1];
                    const u32x4 gt = *(const u32x4*)(GATE + row * 3072 + br * 1024 + col0 + bj * 128);
                    bf16* mp = MG + row * 1024 + col0 + bj * 128;
                    u32x4 od = (u32x4){0u, 0u, 0u, 0u}; if (br > 0) od = *(const u32x4*)mp;
                    float r[8];
                    r[0] = bf_lo(od.x) + bf_lo(gt.x) * v0[0]; r[1] = bf_hi(od.x) + bf_hi(gt.x) * v0[1]; r[2] = bf_lo(od.y) + bf_lo(gt.y) * v0[2]; r[3] = bf_hi(od.y) + bf_hi(gt.y) * v0[3];
                    r[4] = bf_lo(od.z) + bf_lo(gt.z) * v1[0]; r[5] = bf_hi(od.z) + bf_hi(gt.z) * v1[1]; r[6] = bf_lo(od.w) + bf_lo(gt.w) * v1[2]; r[7] = bf_hi(od.w) + bf_hi(gt.w) * v1[3];
                    u32x4 w; w.x = cvt_pk_bf16(r[0], r[1]); w.y = cvt_pk_bf16(r[2], r[3]); w.z = cvt_pk_bf16(r[4], r[5]); w.w = cvt_pk_bf16(r[6], r[7]);
                    *(u32x4*)mp = w; }
                asm volatile("" ::: "memory"); }
    }
};
struct EpiWo {
    static constexpr bool PERM = false;
    float* out;
    __device__ __forceinline__ void operator()(const f32x4 (&acc)[2][2][4][2], const Unit& u, int wr, int wc, int fr, int fq) const {
        const int row0 = u.pm * 256 + wr * 64 + fr, col0 = u.pn * 256 + wc * 32 + 4 * fq;
#pragma unroll
        for (int ai = 0; ai < 2; ++ai)
#pragma unroll
            for (int m = 0; m < 4; ++m) { float* rowp = out + (size_t)(row0 + ai * 128 + m * 16) * DM + col0;
#pragma unroll
                for (int bj = 0; bj < 2; ++bj)
#pragma unroll
                    for (int n = 0; n < 2; ++n) { f32x4* p = (f32x4*)(rowp + bj * 128 + n * 16); const f32x4 o = *p; *p = o * ALPHA + acc[ai][bj][m][n]; } }
    }
};
struct MoeInfo { int c0, c1, c2, c3, tb1, tb2, tb3, tb4; };
__device__ __forceinline__ int moe_bucket(const MoeInfo& I, int rt) { return (rt >= I.tb1) + (rt >= I.tb2) + (rt >= I.tb3); }
__device__ __forceinline__ int moe_tb(const MoeInfo& I, int g) { return g == 0 ? 0 : g == 1 ? I.tb1 : g == 2 ? I.tb2 : I.tb3; }
__device__ __forceinline__ int moe_cnt(const MoeInfo& I, int g) { return g == 0 ? I.c0 : g == 1 ? I.c1 : g == 2 ? I.c2 : I.c3; }
__device__ __forceinline__ MoeInfo moe_info(gu32* cnt) {
    MoeInfo I;
    I.c0 = (int)__hip_atomic_load(cnt + 0, RLX_AGENT); I.c1 = (int)__hip_atomic_load(cnt + 1, RLX_AGENT); I.c2 = (int)__hip_atomic_load(cnt + 2, RLX_AGENT); I.c3 = (int)__hip_atomic_load(cnt + 3, RLX_AGENT);
    I.c0 = __builtin_amdgcn_readfirstlane(I.c0); I.c1 = __builtin_amdgcn_readfirstlane(I.c1); I.c2 = __builtin_amdgcn_readfirstlane(I.c2); I.c3 = __builtin_amdgcn_readfirstlane(I.c3);
    I.tb1 = (I.c0 + 255) >> 8; I.tb2 = I.tb1 + ((I.c1 + 255) >> 8); I.tb3 = I.tb2 + ((I.c2 + 255) >> 8); I.tb4 = I.tb3 + ((I.c3 + 255) >> 8);
    return I;
}
struct MoeOrder {
    MoeInfo I; int G, c; const int* perm;
    __device__ __forceinline__ bool next(int i, Unit& u) const {
        const long L = (long)i * G + c; if (L >= (long)I.tb4 * 4) return false;
        const int rt = (int)(L >> 2), q = (int)(L & 3), g = moe_bucket(I, rt);
        u.pm = rt; u.pn = g * 4 + q; return true;
    }
    __device__ __forceinline__ int arow(const Unit& u, int r) const {
        const int g = u.pn >> 2, slot = (u.pm - moe_tb(I, g)) * 256 + r;
        return slot < moe_cnt(I, g) ? perm[(size_t)g * T + slot] : 0;
    }
    __device__ __forceinline__ void a_ready(const Unit&) const {}
    __device__ __forceinline__ void done(const Unit&) const {}
};
struct EpiMoeUp {
    static constexpr bool PERM = true;
    MoeInfo I; const float* dwp; bf16* HID;
    __device__ __forceinline__ void operator()(const f32x4 (&acc)[2][2][4][2], const Unit& u, int wr, int wc, int fr, int fq) const {
        const int g = u.pn >> 2, el = u.pn & 3, tb = moe_tb(I, g), cnt = moe_cnt(I, g);
        const int r0 = wr * 64 + fr, col0 = el * 128 + wc * 32 + 8 * fq;
#pragma unroll
        for (int ai = 0; ai < 2; ++ai)
#pragma unroll
            for (int m = 0; m < 4; ++m) { const int r = r0 + ai * 128 + m * 16, slot = (u.pm - tb) * 256 + r;
                float dw = 0.f; if (slot < cnt) dw = dwp[((size_t)g * T + slot) * 4 + el];
                const f32x4 g0 = acc[ai][0][m][0], g1 = acc[ai][0][m][1], u0 = acc[ai][1][m][0], u1 = acc[ai][1][m][1];
                float h[8];
#pragma unroll
                for (int j = 0; j < 4; ++j) { h[j] = g0[j] * sigmoid_fast(g0[j]) * u0[j] * dw; h[4 + j] = g1[j] * sigmoid_fast(g1[j]) * u1[j] * dw; }
                u32x4 w; w.x = cvt_pk_bf16(h[0], h[1]); w.y = cvt_pk_bf16(h[2], h[3]); w.z = cvt_pk_bf16(h[4], h[5]); w.w = cvt_pk_bf16(h[6], h[7]);
                *(u32x4*)(HID + (size_t)(u.pm * 256 + r) * 512 + col0) = w; }
    }
};
struct EpiMoeDown {
    static constexpr bool PERM = false;
    MoeInfo I; const int* perm; float* out;
    __device__ __forceinline__ void operator()(const f32x4 (&acc)[2][2][4][2], const Unit& u, int wr, int wc, int fr, int fq) const {
        const int g = u.pn >> 2, pn = u.pn & 3, tb = moe_tb(I, g), cnt = moe_cnt(I, g);
        const int r0 = wr * 64 + fr, col0 = pn * 256 + wc * 32 + 4 * fq;
#pragma unroll
        for (int ai = 0; ai < 2; ++ai)
#pragma unroll
            for (int m = 0; m < 4; ++m) { const int slot = (u.pm - tb) * 256 + r0 + ai * 128 + m * 16;
                if (slot < cnt) { const int tok = perm[(size_t)g * T + slot]; float* rowp = out + (size_t)tok * DM + col0;
#pragma unroll
                    for (int bj = 0; bj < 2; ++bj)
#pragma unroll
                        for (int n = 0; n < 2; ++n) { f32x4* p = (f32x4*)(rowp + bj * 128 + n * 16); const f32x4 o = *p; *p = o * ALPHA + acc[ai][bj][m][n]; } } }
    }
};
struct ProjOrder : pg8::StaticOrder {
    __device__ __forceinline__ bool next(int i, Unit& u) const { if (!pg8::StaticOrder::next(i, u)) return false; u.pn += (u.pn >= 5) ? 1 : 0; return true; }
};
struct MergeOrder {
    pg8::StaticOrder S;
    __device__ __forceinline__ bool next(int i, Unit& u) const { const int ti = i / 3, br = i - ti * 3; if (!S.next(ti, u)) return false; u.pm += br * (T / 256); u.pn += br * 4; return true; }
    __device__ __forceinline__ int arow(const Unit&, int) const { return 0; }
    __device__ __forceinline__ void a_ready(const Unit&) const {}
    __device__ __forceinline__ void done(const Unit&) const {}
};

struct Frame {
    LAS unsigned char* lds;
    volatile LAS unsigned* MISC;
    gu32* ctl;
    int tid, lane, wave, vcu, G, bx;
};

__device__ __forceinline__ void tr_block(const float* s, int lds_, bf16* d, int ldd, LAS float* scr, int lane) {
#pragma unroll 8
    for (int i = 0; i < 32; ++i) { const int kk = 2 * i + (lane >> 5); scr[kk * 33 + (lane & 31)] = s[(size_t)kk * lds_ + (lane & 31)]; }
    LDS_WAIT(); asm volatile("" ::: "memory");
    const int c = lane & 7;
#pragma unroll
    for (int j = 0; j < 4; ++j) { const int n = (lane >> 3) + 8 * j; const LAS float* p = scr + (8 * c) * 33 + n;
        u32x4 o; o.x = cvt_pk_bf16(p[0 * 33], p[1 * 33]); o.y = cvt_pk_bf16(p[2 * 33], p[3 * 33]); o.z = cvt_pk_bf16(p[4 * 33], p[5 * 33]); o.w = cvt_pk_bf16(p[6 * 33], p[7 * 33]);
        *(u32x4*)(d + (size_t)n * ldd + 8 * c) = o; }
    LDS_WAIT(); asm volatile("" ::: "memory");
}
__device__ __forceinline__ void convert_weights(const Frame& F0, unsigned char* ws, int l, const float* w_in, const float* w_br, const float* w_o, const float* w_gate, const float* w_up, const float* w_down, const float* sg_w) {
    Frame F = F0; F.wave = opqs(F0.wave); F.vcu = opqs(F0.vcu); F.G = opqs(F0.G); F.lane = cur_lane(); F.tid = F.wave * 64 + F.lane;
    LAS float* scr = (LAS float*)(F.lds + F.wave * 16384);
    const int gw = F.vcu * NWAVES + F.wave, NGW = F.G * NWAVES;
    bf16* WIN = (bf16*)(ws + WS_WIN); bf16* WBR = (bf16*)(ws + WS_WBR); bf16* WO = (bf16*)(ws + WS_WO); bf16* WGU = (bf16*)(ws + WS_WGU); bf16* WD = (bf16*)(ws + WS_WD); bf16* SGW = (bf16*)(ws + WS_SGW);
    const float* win = w_in + (size_t)l * DM * INC; const float* wbr = w_br + (size_t)l * 3 * 256 * DM; const float* wo = w_o + (size_t)l * DM * DM;
    const float* wg = w_gate + (size_t)l * 16 * DM * 128; const float* wu = w_up + (size_t)l * 16 * DM * 128; const float* wd = w_down + (size_t)l * 16 * 128 * DM;
    constexpr int I_IN = 16 * 160, I_BR = 3 * 4 * 32, I_O = 16 * 32, I_G = 16 * 64, I_U = I_G, I_D = 16 * 64;
    constexpr int NIT = I_IN + I_BR + I_O + I_G + I_U + I_D;
    for (int it = gw; it < NIT; it += NGW) {
        int r = it;
        if (r < I_IN) { const int kb = r / 160, nb = r % 160; tr_block(win + (size_t)(64 * kb) * INC + 32 * nb, INC, WIN + (size_t)(32 * nb) * DM + 64 * kb, DM, scr, F.lane); continue; } r -= I_IN;
        if (r < I_BR) { const int br = r / 128, q = r % 128, kb = q / 32, nb = q % 32; tr_block(wbr + (size_t)br * 256 * DM + (size_t)(64 * kb) * DM + 32 * nb, DM, WBR + (size_t)br * DM * 256 + (size_t)(32 * nb) * 256 + 64 * kb, 256, scr, F.lane); continue; } r -= I_BR;
        if (r < I_O) { const int kb = r / 32, nb = r % 32; tr_block(wo + (size_t)(64 * kb) * DM + 32 * nb, DM, WO + (size_t)(32 * nb) * DM + 64 * kb, DM, scr, F.lane); continue; } r -= I_O;
        if (r < I_G + I_U) { const bool up = r >= I_G; if (up) r -= I_G; const int e = r / 64, q = r % 64, kb = q / 4, nb = q % 4; const float* src = (up ? wu : wg) + (size_t)e * DM * 128;
            tr_block(src + (size_t)(64 * kb) * 128 + 32 * nb, 128, WGU + (size_t)(e >> 2) * DM * DM + (size_t)((e & 3) * 256 + (up ? 128 : 0) + 32 * nb) * DM + 64 * kb, DM, scr, F.lane); continue; } r -= I_G + I_U;
        { const int e = r / 64, q = r % 64, kb = q / 32, nb = q % 32;
          tr_block(wd + (size_t)e * 128 * DM + (size_t)(64 * kb) * DM + 32 * nb, DM, WD + (size_t)(e >> 2) * DM * 512 + (size_t)(32 * nb) * 512 + (e & 3) * 128 + 64 * kb, 512, scr, F.lane); }
    }
    const float* sg = sg_w + (size_t)l * 4 * 128 * 128;
    for (int i = F.vcu * NTHREADS + F.tid; i < 4 * 128 * 128 / 2; i += F.G * NTHREADS) { const int e = 2 * i, t = (e >> 7) & 127, s = e & 127; const f32x2 v = *(const f32x2*)(sg + e);
        ((unsigned*)SGW)[i] = cvt_pk_bf16(s <= t ? v.x : 0.f, (s + 1) <= t ? v.y : 0.f); }
}

__device__ __forceinline__ void ln_row(const float* src, const f32x4 (&gm)[4], const f32x4 (&bt)[4], int lane, f32x4 (&y)[4]) {
    const f32x4* xr = (const f32x4*)src + lane; float s = 0.f;
#pragma unroll
    for (int j = 0; j < 4; ++j) { y[j] = xr[64 * j]; s += (y[j].x + y[j].y) + (y[j].z + y[j].w); }
    const float mean = wave_sum(s, lane) * (1.f / DM); float s2 = 0.f;
#pragma unroll
    for (int j = 0; j < 4; ++j) { y[j] = y[j] - mean; s2 += (y[j].x * y[j].x + y[j].y * y[j].y) + (y[j].z * y[j].z + y[j].w * y[j].w); }
    const float rstd = 1.f / sqrtf(wave_sum(s2, lane) * (1.f / DM) + LN_EPS);
#pragma unroll
    for (int j = 0; j < 4; ++j) y[j] = y[j] * rstd * gm[j] + bt[j];
}
__device__ __forceinline__ void store_row(const f32x4 (&y)[4], float* of, bf16* ob, int lane) {
    f32x4* o4 = (f32x4*)of + lane; u32x2* o8 = (u32x2*)ob + lane;
#pragma unroll
    for (int j = 0; j < 4; ++j) { o4[64 * j] = y[j]; u32x2 w; w.x = cvt_pk_bf16(y[j].x, y[j].y); w.y = cvt_pk_bf16(y[j].z, y[j].w); o8[64 * j] = w; }
}
__device__ __forceinline__ void ln_phase(const Frame& F0, const float* src, const float* gam, const float* bet, float* of, bf16* ob) {
    Frame F = F0; F.wave = opqs(F0.wave); F.vcu = opqs(F0.vcu); F.G = opqs(F0.G); F.lane = cur_lane(); F.tid = F.wave * 64 + F.lane;
    f32x4 gm[4], bt[4];
#pragma unroll
    for (int j = 0; j < 4; ++j) { gm[j] = ((const f32x4*)gam)[F.lane + 64 * j]; bt[j] = ((const f32x4*)bet)[F.lane + 64 * j]; }
    const int gw = F.vcu * NWAVES + F.wave, NGW = F.G * NWAVES;
    for (int m = gw; m < T; m += NGW) { f32x4 y[4]; ln_row(src + (size_t)m * DM, gm, bt, F.lane, y); store_row(y, of + (size_t)m * DM, ob + (size_t)m * DM, F.lane); }
}

__device__ __forceinline__ void ln_router_phase(const Frame& F0, float* out, bf16* hb, const float* gam, const float* bet, const float* w_router, const float* rbias, int* perm, float* dwp, gu32* gcnt) {
    Frame F = F0; F.wave = opqs(F0.wave); F.vcu = opqs(F0.vcu); F.G = opqs(F0.G); F.lane = cur_lane(); F.tid = F.wave * 64 + F.lane;
    LAS float* wrs = (LAS float*)F.lds;
    LAS int* lcnt = (LAS int*)(F.lds + 65536);
    LAS int* lbase = (LAS int*)(F.lds + 65536 + 16);
    LAS int* rinfo = (LAS int*)(F.lds + 65536 + 64);
    LAS f32x4* dwl = (LAS f32x4*)(F.lds + 65536 + 2048);
    for (int i = F.tid; i < 16384; i += NTHREADS) { const int k = i >> 4, e = i & 15; wrs[e * 1024 + k] = w_router[i]; }
    if (F.tid < 4) lcnt[F.tid] = 0;
    if (F.tid < 256) rinfo[F.tid] = -1;
    f32x4 gm[4], bt[4];
#pragma unroll
    for (int j = 0; j < 4; ++j) { gm[j] = ((const f32x4*)gam)[F.lane + 64 * j]; bt[j] = ((const f32x4*)bet)[F.lane + 64 * j]; }
    float rb[16];
#pragma unroll
    for (int e = 0; e < 16; ++e) rb[e] = rbias[e];
    __syncthreads();
    const int gw = F.vcu * NWAVES + F.wave, NGW = F.G * NWAVES;
    int it = 0;
    for (int m = gw; m < T; m += NGW, ++it) {
        f32x4 y[4]; ln_row(out + (size_t)m * DM, gm, bt, F.lane, y); store_row(y, out + (size_t)m * DM, hb + (size_t)m * DM, F.lane);
        float sc[16], sel[16];
#pragma unroll
        for (int e = 0; e < 16; ++e) { float p = 0.f;
#pragma unroll
            for (int j = 0; j < 4; ++j) { const f32x4 w = *(const LAS f32x4*)(wrs + e * 1024 + 256 * j + 4 * F.lane); p += (y[j].x * w.x + y[j].y * w.y) + (y[j].z * w.z + y[j].w * w.w); }
            const float lg = wave_sum(p, F.lane); sc[e] = 1.f / (1.f + __expf(-lg)); sel[e] = sc[e] + rb[e]; }
        float gs[4];
#pragma unroll
        for (int g = 0; g < 4; ++g) { const float a = sel[4 * g], b = sel[4 * g + 1], c = sel[4 * g + 2], d = sel[4 * g + 3];
            const float h1 = fmaxf(a, b), l1 = fminf(a, b), h2 = fmaxf(c, d), l2 = fminf(c, d); gs[g] = fmaxf(h1, h2) + fmaxf(fminf(h1, h2), fmaxf(l1, l2)); }
        int bg = 0; float bs = gs[0];
#pragma unroll
        for (int g = 1; g < 4; ++g) if (gs[g] > bs) { bs = gs[g]; bg = g; }
        float v[4], s4[4];
#pragma unroll
        for (int j = 0; j < 4; ++j) { v[j] = bg == 0 ? sel[j] : bg == 1 ? sel[4 + j] : bg == 2 ? sel[8 + j] : sel[12 + j]; s4[j] = bg == 0 ? sc[j] : bg == 1 ? sc[4 + j] : bg == 2 ? sc[8 + j] : sc[12 + j]; }
        int i1 = 0; float m1 = v[0];
#pragma unroll
        for (int j = 1; j < 4; ++j) if (v[j] > m1) { m1 = v[j]; i1 = j; }
        int i2 = -1; float m2 = -3.0e38f;
#pragma unroll
        for (int j = 0; j < 4; ++j) if (j != i1 && v[j] > m2) { m2 = v[j]; i2 = j; }
        const float s1 = i1 == 0 ? s4[0] : i1 == 1 ? s4[1] : i1 == 2 ? s4[2] : s4[3], s2 = i2 == 0 ? s4[0] : i2 == 1 ? s4[1] : i2 == 2 ? s4[2] : s4[3];
        const float inv = 1.f / (s1 + s2), w1 = s1 * inv, w2 = s2 * inv;
        f32x4 dw;
        dw.x = i1 == 0 ? w1 : i2 == 0 ? w2 : 0.f; dw.y = i1 == 1 ? w1 : i2 == 1 ? w2 : 0.f; dw.z = i1 == 2 ? w1 : i2 == 2 ? w2 : 0.f; dw.w = i1 == 3 ? w1 : i2 == 3 ? w2 : 0.f;
        if (F.lane == 0) { const int li = it * NWAVES + F.wave; if (li < 256) { const int rank = atomicAdd((int*)&lcnt[bg], 1); rinfo[li] = m | (bg << 16) | (rank << 18); dwl[li] = dw; } }
    }
    __syncthreads();
    if (F.tid < 4) lbase[F.tid] = (int)__hip_atomic_fetch_add(gcnt + F.tid, (unsigned)lcnt[F.tid], RLX_AGENT);
    __syncthreads();
    if (F.tid < 256) { const int info = rinfo[F.tid]; if (info >= 0) { const int tok = info & 0xffff, g = (info >> 16) & 3, rank = info >> 18; const size_t slot = (size_t)g * T + lbase[g] + rank;
        perm[slot] = tok; ((f32x4*)dwp)[slot] = dwl[F.tid]; } }
    __syncthreads();
}

__device__ __forceinline__ void conv_phase(const Frame& F0, const bf16* PA, const float* cw, bf16* Y0) {
    Frame F = F0; F.wave = opqs(F0.wave); F.vcu = opqs(F0.vcu); F.G = opqs(F0.G); F.lane = cur_lane(); F.tid = F.wave * 64 + F.lane;
    for (int rr = F.vcu * NTHREADS + F.tid; rr < (T / 16) * 32; rr += F.G * NTHREADS) {
        const int co = rr & 31, run = rr >> 5, t0 = run * 16, c0 = co * 8;
        float w[3][8];
#pragma unroll
        for (int j = 0; j < 3; ++j) { const f32x4 a = *(const f32x4*)(cw + j * 256 + c0), b = *(const f32x4*)(cw + j * 256 + c0 + 4); w[j][0] = a.x; w[j][1] = a.y; w[j][2] = a.z; w[j][3] = a.w; w[j][4] = b.x; w[j][5] = b.y; w[j][6] = b.z; w[j][7] = b.w; }
        float u1[8], u2[8];
        const bool first = (t0 % SEQ) == 0;
#pragma unroll
        for (int q = 0; q < 8; ++q) { u1[q] = 0.f; u2[q] = 0.f; }
        if (!first) {
            const u32x4 h1 = *(const u32x4*)(PA + (size_t)(t0 - 1) * 768 + c0), g1 = *(const u32x4*)(PA + (size_t)(t0 - 1) * 768 + 512 + c0);
            const u32x4 h2 = *(const u32x4*)(PA + (size_t)(t0 - 2) * 768 + c0), g2 = *(const u32x4*)(PA + (size_t)(t0 - 2) * 768 + 512 + c0);
#pragma unroll
            for (int q = 0; q < 4; ++q) { u1[2 * q] = bf_lo(h1[q]) * bf_lo(g1[q]); u1[2 * q + 1] = bf_hi(h1[q]) * bf_hi(g1[q]); u2[2 * q] = bf_lo(h2[q]) * bf_lo(g2[q]); u2[2 * q + 1] = bf_hi(h2[q]) * bf_hi(g2[q]); }
        }
#pragma unroll 4
        for (int i = 0; i < 16; ++i) { const bf16* row = PA + (size_t)(t0 + i) * 768 + c0;
            const u32x4 hh = *(const u32x4*)row, bb = *(const u32x4*)(row + 256), cc = *(const u32x4*)(row + 512);
            float u0[8], yv[8];
#pragma unroll
            for (int q = 0; q < 4; ++q) { u0[2 * q] = bf_lo(hh[q]) * bf_lo(cc[q]); u0[2 * q + 1] = bf_hi(hh[q]) * bf_hi(cc[q]); }
#pragma unroll
            for (int q = 0; q < 8; ++q) { const float bgv = (q & 1) ? bf_hi(bb[q >> 1]) : bf_lo(bb[q >> 1]); yv[q] = bgv * (w[0][q] * u2[q] + w[1][q] * u1[q] + w[2][q] * u0[q]); u2[q] = u1[q]; u1[q] = u0[q]; }
            u32x4 o; o.x = cvt_pk_bf16(yv[0], yv[1]); o.y = cvt_pk_bf16(yv[2], yv[3]); o.z = cvt_pk_bf16(yv[4], yv[5]); o.w = cvt_pk_bf16(yv[6], yv[7]);
            *(u32x4*)(Y0 + (size_t)(t0 + i) * 256 + c0) = o; }
    }
}

__device__ __forceinline__ void attn_unit(const bf16* Q, const bf16* Kb, const bf16* VT, bf16* Y1, int b, int hd, int qt, int lane) {
    const int r = lane & 31, h = lane >> 5;
    const size_t tokb = (size_t)b * SEQ;
    bf16x8 qf[4];
    { const bf16* qp = Q + (tokb + qt * 32 + r) * 256 + hd * 64 + 8 * h;
#pragma unroll
      for (int s = 0; s < 4; ++s) qf[s] = *(const bf16x8*)(qp + 16 * s); }
    f32x16 o0, o1;
#pragma unroll
    for (int i = 0; i < 16; ++i) { o0[i] = 0.f; o1[i] = 0.f; }
    float R = 0.f;
    for (int kt = qt; kt >= 0; --kt) {
        const bf16* kp = Kb + (tokb + kt * 32 + r) * 256 + hd * 64 + 8 * h;
        bf16x8 kf[4];
#pragma unroll
        for (int s = 0; s < 4; ++s) kf[s] = *(const bf16x8*)(kp + 16 * s);
        bf16x8 vf[2][2];
#pragma unroll
        for (int db = 0; db < 2; ++db)
#pragma unroll
            for (int s = 0; s < 2; ++s) { const bf16* vp = VT + (size_t)(hd * 64 + db * 32 + r) * T + tokb + kt * 32 + 16 * s + 4 * h;
                const u32x2 lo = *(const u32x2*)vp, hi = *(const u32x2*)(vp + 8); const u32x4 w = (u32x4){lo.x, lo.y, hi.x, hi.y}; vf[db][s] = __builtin_bit_cast(bf16x8, w); }
        f32x16 st;
#pragma unroll
        for (int i = 0; i < 16; ++i) st[i] = 0.f;
#pragma unroll
        for (int s = 0; s < 4; ++s) st = __builtin_amdgcn_mfma_f32_32x32x16_bf16(kf[s], qf[s], st, 0, 0, 0);
        float ln[16], lb[16];
        const bool diag = (kt == qt);
#pragma unroll
        for (int i = 0; i < 16; ++i) { const float z = st[i]; const float e = __expf(-fabsf(z)); const float sp = fmaxf(z, 0.f) + __logf(1.f + e);
            const int kidx = (i & 3) + 8 * (i >> 2) + 4 * h; const bool valid = !diag || (kidx < r);
            ln[i] = valid ? -sp : 0.f; lb[i] = valid ? (z - sp) : -1.0e30f; }
        float Gs[4], Go[4];
#pragma unroll
        for (int g = 0; g < 4; ++g) { Gs[g] = (ln[4 * g] + ln[4 * g + 1]) + (ln[4 * g + 2] + ln[4 * g + 3]); Go[g] = shfl_xor_l(Gs[g], 32, lane); }
        float tail[4]; tail[3] = 0.f; tail[2] = Gs[3] + Go[3]; tail[1] = tail[2] + (Gs[2] + Go[2]); tail[0] = tail[1] + (Gs[1] + Go[1]);
        const float total = tail[0] + (Gs[0] + Go[0]);
        float p[16];
#pragma unroll
        for (int g = 0; g < 4; ++g) { const float base = R + tail[g] + (h == 0 ? Go[g] : 0.f);
            const float w3 = base, w2 = w3 + ln[4 * g + 3], w1 = w2 + ln[4 * g + 2], w0 = w1 + ln[4 * g + 1];
            p[4 * g + 3] = __expf(lb[4 * g + 3] + w3); p[4 * g + 2] = __expf(lb[4 * g + 2] + w2); p[4 * g + 1] = __expf(lb[4 * g + 1] + w1); p[4 * g] = __expf(lb[4 * g] + w0); }
        R += total;
        bf16x8 pf[2];
#pragma unroll
        for (int s = 0; s < 2; ++s) { u32x4 w; w.x = cvt_pk_bf16(p[8 * s], p[8 * s + 1]); w.y = cvt_pk_bf16(p[8 * s + 2], p[8 * s + 3]); w.z = cvt_pk_bf16(p[8 * s + 4], p[8 * s + 5]); w.w = cvt_pk_bf16(p[8 * s + 6], p[8 * s + 7]); pf[s] = __builtin_bit_cast(bf16x8, w); }
#pragma unroll
        for (int s = 0; s < 2; ++s) { o0 = __builtin_amdgcn_mfma_f32_32x32x16_bf16(vf[0][s], pf[s], o0, 0, 0, 0); o1 = __builtin_amdgcn_mfma_f32_32x32x16_bf16(vf[1][s], pf[s], o1, 0, 0, 0); }
        if (__all(R < -32.f)) break;
    }
    bf16* yp = Y1 + (tokb + qt * 32 + r) * 256 + hd * 64 + 4 * h;
#pragma unroll
    for (int g = 0; g < 4; ++g) { u32x2 w; w.x = cvt_pk_bf16(o0[4 * g], o0[4 * g + 1]); w.y = cvt_pk_bf16(o0[4 * g + 2], o0[4 * g + 3]); *(u32x2*)(yp + 8 * g) = w;
        u32x2 w1; w1.x = cvt_pk_bf16(o1[4 * g], o1[4 * g + 1]); w1.y = cvt_pk_bf16(o1[4 * g + 2], o1[4 * g + 3]); *(u32x2*)(yp + 32 + 8 * g) = w1; }
}
__device__ __forceinline__ void attn_phase(const Frame& F0, const bf16* Q, const bf16* Kb, const bf16* VT, bf16* Y1) {
    Frame F = F0; F.wave = opqs(F0.wave); F.vcu = opqs(F0.vcu); F.G = opqs(F0.G); F.lane = cur_lane(); F.tid = F.wave * 64 + F.lane;
    const int gw = F.vcu * NWAVES + F.wave, NGW = F.G * NWAVES;
    for (int u = gw; u < (T / 32) * 4; u += NGW) { const int hd = u >> 10, tt = u & 1023, b = tt >> 9, qt = tt & 511; attn_unit(Q, Kb, VT, Y1, b, hd, qt, F.lane); }
}

constexpr int VTP = 136;
__device__ __forceinline__ void gmlp_phase(const Frame& F0, const bf16* UC, const bf16* SGW, const float* sgb, const float* lng, const float* lnb, bf16* Y2) {
    Frame F = F0; F.wave = opqs(F0.wave); F.vcu = opqs(F0.vcu); F.G = opqs(F0.G); F.lane = cur_lane(); F.tid = F.wave * 64 + F.lane;
    LAS bf16* VTl = (LAS bf16*)F.lds;
    const int lane = F.lane, w = F.wave, r = lane & 31, h = lane >> 5;
    const f32x4 g4 = ((const f32x4*)lng)[lane], b4 = ((const f32x4*)lnb)[lane];
    for (int ch = F.vcu; ch < T / 128; ch += F.G) {
        const size_t tok0 = (size_t)ch * 128;
        for (int i = 0; i < 16; ++i) { const int s = w * 16 + i; const u32x2 raw = *(const u32x2*)(UC + (tok0 + s) * 512 + 256 + 4 * lane);
            float x0 = bf_lo(raw.x), x1 = bf_hi(raw.x), x2 = bf_lo(raw.y), x3 = bf_hi(raw.y);
            const float mean = wave_sum((x0 + x1) + (x2 + x3), lane) * (1.f / 256.f); x0 -= mean; x1 -= mean; x2 -= mean; x3 -= mean;
            const float rstd = 1.f / sqrtf(wave_sum((x0 * x0 + x1 * x1) + (x2 * x2 + x3 * x3), lane) * (1.f / 256.f) + LN_EPS);
            const unsigned p01 = cvt_pk_bf16(x0 * rstd * g4.x + b4.x, x1 * rstd * g4.y + b4.y), p23 = cvt_pk_bf16(x2 * rstd * g4.z + b4.z, x3 * rstd * g4.w + b4.w);
            VTl[(4 * lane + 0) * VTP + s] = (bf16)(p01 & 0xffffu); VTl[(4 * lane + 1) * VTP + s] = (bf16)(p01 >> 16);
            VTl[(4 * lane + 2) * VTP + s] = (bf16)(p23 & 0xffffu); VTl[(4 * lane + 3) * VTP + s] = (bf16)(p23 >> 16); }
        __syncthreads();
        const int g = w >> 1, th = w & 1;
        f32x16 acc[2][2];
#pragma unroll
        for (int a = 0; a < 2; ++a)
#pragma unroll
            for (int b = 0; b < 2; ++b)
#pragma unroll
                for (int i = 0; i < 16; ++i) acc[a][b][i] = 0.f;
#pragma unroll 2
        for (int ks = 0; ks < 8; ++ks) {
            bf16x8 af[2], bfr[2];
#pragma unroll
            for (int cb = 0; cb < 2; ++cb) af[cb] = *(const LAS bf16x8*)(VTl + (g * 64 + cb * 32 + r) * VTP + 16 * ks + 8 * h);
#pragma unroll
            for (int tb = 0; tb < 2; ++tb) bfr[tb] = *(const bf16x8*)(SGW + ((size_t)g * 128 + 64 * th + 32 * tb + r) * 128 + 16 * ks + 8 * h);
#pragma unroll
            for (int cb = 0; cb < 2; ++cb)
#pragma unroll
                for (int tb = 0; tb < 2; ++tb) acc[cb][tb] = __builtin_amdgcn_mfma_f32_32x32x16_bf16(af[cb], bfr[tb], acc[cb][tb], 0, 0, 0);
        }
#pragma unroll
        for (int tb = 0; tb < 2; ++tb) { const int t = 64 * th + 32 * tb + r; const float bias = sgb[g * 128 + t]; const size_t tok = tok0 + t;
#pragma unroll
            for (int cb = 0; cb < 2; ++cb)
#pragma unroll
                for (int q = 0; q < 4; ++q) { const int c0 = g * 64 + cb * 32 + 8 * q + 4 * h; const u32x2 uu = *(const u32x2*)(UC + tok * 512 + c0);
                    u32x2 o; o.x = cvt_pk_bf16(bf_lo(uu.x) * (acc[cb][tb][4 * q] + bias), bf_hi(uu.x) * (acc[cb][tb][4 * q + 1] + bias));
                    o.y = cvt_pk_bf16(bf_lo(uu.y) * (acc[cb][tb][4 * q + 2] + bias), bf_hi(uu.y) * (acc[cb][tb][4 * q + 3] + bias));
                    *(u32x2*)(Y2 + tok * 256 + c0) = o; } }
        __syncthreads();
    }
}

template <class Tp> __device__ __forceinline__ Tp* karg(int idx) {
    int off = 8 * idx; asm volatile("" : "+s"(off));
    const __attribute__((address_space(4))) char* kp = (const __attribute__((address_space(4))) char*)__builtin_amdgcn_kernarg_segment_ptr();
    const unsigned long long v = *(const __attribute__((address_space(4))) unsigned long long*)(kp + off);
    return (Tp*)(GAS Tp*)v;
}
#define KIN(i) karg<const float>(i)
#define KOUT() karg<float>(21)
#define KWS() karg<unsigned char>(22)
struct Args { const float* in[21]; float* out; unsigned char* ws; int ph_lo, ph_hi; };
__global__ void __launch_bounds__(NTHREADS, 2) fwd(Args args) {
    extern __shared__ __attribute__((aligned(16))) unsigned char lds[];
    Frame F;
    F.lds = (LAS unsigned char*)lds;
    F.MISC = (volatile LAS unsigned*)(F.lds + MISC_OFF);
    F.wave = __builtin_amdgcn_readfirstlane((int)threadIdx.x >> 6); F.lane = 0; F.tid = 0;
    F.G = gridDim.x; F.bx = blockIdx.x; { const int bx = blockIdx.x; F.vcu = (F.G % 8 == 0) ? (bx % 8) * (F.G / 8) + bx / 8 : bx; }
    F.ctl = (gu32*)(KWS() + WS_CTL);
    for (int u = threadIdx.x; u < (LDS_BYTES - LDSCTL_OFF) / 4; u += NTHREADS) ((LAS unsigned*)(F.lds + LDSCTL_OFF))[u] = 0u;
    __syncthreads();
    XcdBarrier bar = xcd_barrier_post((unsigned*)(F.ctl + CW_BAR), F.MISC + 8);
    const int lo = args.ph_lo, hi = args.ph_hi;
#define IN(k) (lo <= (k) && (k) < hi)
#define SEAM(k) do { if (IN(k) && IN((k) + 1)) { XcdBarrier b2; b2.bar = (unsigned*)((gu32*)(KWS() + WS_CTL) + CW_BAR); b2.x = (unsigned)opqs((int)bar.x); b2.st = F.MISC + 8; xcd_barrier(b2, opqs(F.wave) == 0 && cur_lane() == 0); } } while (0)

    if (IN(0)) {
        convert_weights(F, KWS(), 0, KIN(3), KIN(10), KIN(11), KIN(16), KIN(17), KIN(18), KIN(6));
        ln_phase(F, KIN(0), KIN(1), KIN(2), KOUT(), (bf16*)(KWS() + WS_HB));
        SEAM(0);
    }
    for (int l = 0; l < DEPTH; ++l) {
        const int p0 = 1 + 8 * l;
        if (IN(p0)) {
            { unsigned char* ws = KWS(); pg8::Gemm g{(bf16*)(ws + WS_HB), (bf16*)(ws + WS_WIN), T, 19 * 256, DM}; ProjOrder S; S.init(T, 19 * 256, opqs(F.G), opqs(F.bx));
              EpiProj E{(bf16*)(ws + WS_PA), (bf16*)(ws + WS_Q), (bf16*)(ws + WS_K), (bf16*)(ws + WS_UC), (bf16*)(ws + WS_GATE), KIN(4) + (size_t)l * 3 * DM};
              pg8::gemm_phase<EpiProj, ProjOrder, true, false>(F.lds, opqs(F.wave), g, S, E); }
            { unsigned char* ws = KWS(); pg8::Gemm g{(bf16*)(ws + WS_WIN) + (size_t)1280 * DM, (bf16*)(ws + WS_HB), 256, T, DM}; pg8::StaticOrder S; { const int G_ = opqs(F.G); S.init(256, T, G_, (opqs(F.bx) + G_ / 2) % G_); }
              EpiVt E{(bf16*)(ws + WS_VT)};
              pg8::gemm_phase<EpiVt, pg8::StaticOrder, true, false>(F.lds, opqs(F.wave), g, S, E); }
            SEAM(p0);
        }
        if (IN(p0 + 1)) {
            { unsigned char* ws = KWS(); attn_phase(F, (bf16*)(ws + WS_Q), (bf16*)(ws + WS_K), (bf16*)(ws + WS_VT), (bf16*)(ws + WS_Y) + (size_t)T * 256); }
            { unsigned char* ws = KWS(); gmlp_phase(F, (bf16*)(ws + WS_UC), (bf16*)(ws + WS_SGW), KIN(7) + (size_t)l * 512, KIN(8) + (size_t)l * 256, KIN(9) + (size_t)l * 256, (bf16*)(ws + WS_Y) + (size_t)2 * T * 256); }
            { unsigned char* ws = KWS(); conv_phase(F, (bf16*)(ws + WS_PA), KIN(5) + (size_t)l * 768, (bf16*)(ws + WS_Y)); }
            SEAM(p0 + 1);
        }
        if (IN(p0 + 2)) {
            unsigned char* ws = KWS(); pg8::Gemm g{(bf16*)(ws + WS_Y), (bf16*)(ws + WS_WBR), 3 * T, 3 * DM, 256}; MergeOrder S; S.S.init(T, DM, opqs(F.G), opqs(F.bx));
            EpiMerge E{(bf16*)(ws + WS_GATE), (bf16*)(ws + WS_HB)};
            pg8::gemm_phase<EpiMerge, MergeOrder, true, false>(F.lds, opqs(F.wave), g, S, E);
            SEAM(p0 + 2);
        }
        if (IN(p0 + 3)) {
            unsigned char* ws = KWS(); pg8::Gemm g{(bf16*)(ws + WS_HB), (bf16*)(ws + WS_WO), T, DM, DM}; pg8::StaticOrder S; S.init(T, DM, opqs(F.G), opqs(F.bx));
            EpiWo E{KOUT()};
            pg8::gemm_phase<EpiWo, pg8::StaticOrder, true, false>(F.lds, opqs(F.wave), g, S, E);
            SEAM(p0 + 3);
        }
        if (IN(p0 + 4)) {
            unsigned char* ws = KWS();
            ln_router_phase(F, KOUT(), (bf16*)(ws + WS_HB), KIN(12) + (size_t)l * DM, KIN(13) + (size_t)l * DM, KIN(14), KIN(15), (int*)(ws + WS_PERM), (float*)(ws + WS_DWP), (gu32*)(KWS() + WS_CTL) + CW_CNT + 64 * l);
            SEAM(p0 + 4);
        }
        if (IN(p0 + 5)) {
            MoeInfo MI = moe_info((gu32*)(KWS() + WS_CTL) + CW_CNT + 64 * l);
            unsigned char* ws = KWS(); pg8::Gemm g{(bf16*)(ws + WS_HB), (bf16*)(ws + WS_WGU), T, 4 * DM, DM}; MoeOrder S{MI, opqs(F.G), opqs(F.bx), (int*)(ws + WS_PERM)};
            EpiMoeUp E{MI, (float*)(ws + WS_DWP), (bf16*)(ws + WS_PA)};
            pg8::gemm_phase<EpiMoeUp, MoeOrder, true, true>(F.lds, opqs(F.wave), g, S, E);
            SEAM(p0 + 5);
        }
        if (IN(p0 + 6)) {
            MoeInfo MI = moe_info((gu32*)(KWS() + WS_CTL) + CW_CNT + 64 * l);
            unsigned char* ws = KWS(); pg8::Gemm g{(bf16*)(ws + WS_PA), (bf16*)(ws + WS_WD), T + 1024, 4 * DM, 512}; MoeOrder S{MI, opqs(F.G), opqs(F.bx), (int*)(ws + WS_PERM)};
            EpiMoeDown E{MI, (int*)(ws + WS_PERM), KOUT()};
            pg8::gemm_phase<EpiMoeDown, MoeOrder, true, false>(F.lds, opqs(F.wave), g, S, E);
            SEAM(p0 + 6);
        }
        if (IN(p0 + 7)) {
            if (l + 1 < DEPTH) convert_weights(F, KWS(), l + 1, KIN(3), KIN(10), KIN(11), KIN(16), KIN(17), KIN(18), KIN(6));
            { float* out = KOUT(); ln_phase(F, out, KIN(19) + (size_t)l * DM, KIN(20) + (size_t)l * DM, out, (bf16*)(KWS() + WS_HB)); }
            SEAM(p0 + 7);
        }
    }
#undef IN
#undef SEAM
}

extern "C" void kernel_launch(void* const* d_in, const int* in_sizes, int n_in, void* d_out, int out_size, void* d_ws, size_t ws_size, hipStream_t stream) {
    static int grid = 0;
    if (grid == 0) {
        if (n_in != 21 || out_size != T * DM || ws_size < WS_END) { fprintf(stderr, "kernel_launch: unexpected shapes (n_in %d out %d ws %zu)\n", n_in, out_size, ws_size); grid = -1; return; }
        int dev = 0, cus = 0, per_cu = 0;
        if (hipGetDevice(&dev) != hipSuccess || hipDeviceGetAttribute(&cus, hipDeviceAttributeMultiprocessorCount, dev) != hipSuccess) { grid = -1; return; }
        if (hipFuncSetAttribute((const void*)fwd, hipFuncAttributeMaxDynamicSharedMemorySize, LDS_BYTES) != hipSuccess) { fprintf(stderr, "kernel_launch: hipFuncSetAttribute failed\n"); grid = -1; return; }
        if (hipOccupancyMaxActiveBlocksPerMultiprocessor(&per_cu, (const void*)fwd, NTHREADS, LDS_BYTES) != hipSuccess || per_cu < 1) fprintf(stderr, "kernel_launch: occupancy query says %d\n", per_cu);
        (void)hipGetLastError();
        grid = cus;
    }
    if (grid < 0) return;
    (void)hipMemsetAsync((char*)d_ws + WS_CTL, 0, CTL_ZERO_BYTES, stream);
    Args a{};
    for (int i = 0; i < 21; ++i) a.in[i] = (const float*)d_in[i];
    a.out = (float*)d_out; a.ws = (unsigned char*)d_ws;
#if MK_PER_PHASE
    for (int p = 0; p < NPH; ++p) { a.ph_lo = p; a.ph_hi = p + 1; hipLaunchKernelGGL(fwd, dim3(grid), dim3(NTHREADS), LDS_BYTES, stream, a); }
#else
    a.ph_lo = 0; a.ph_hi = NPH;
    hipLaunchKernelGGL(fwd, dim3(grid), dim3(NTHREADS), LDS_BYTES, stream, a);
#endif
}
```

```cpp
#include <hip/hip_runtime.h>
#include <cstdio>
#include <cstdint>

#ifndef MK_PER_PHASE
#define MK_PER_PHASE 0
#endif

#ifndef REP_P0
#define REP_P0 1
#define REP_P1 1
#define REP_P2 1
#define REP_P3 1
#define REP_P4 1
#define REP_P5 1
#define REP_P6 1
#define REP_P7 1
#define REP_P8 1
#define REP_BAR 1
#define REP_P2A 1
#define REP_P2B 1
#define REP_P2C 1
#endif
#define GAS __attribute__((address_space(1)))
#define LAS __attribute__((address_space(3)))
typedef unsigned short bf16;
typedef short bf16x8 __attribute__((ext_vector_type(8)));
typedef float f32x4 __attribute__((ext_vector_type(4)));
typedef float f32x2 __attribute__((ext_vector_type(2)));
typedef float f32x16 __attribute__((ext_vector_type(16)));
typedef unsigned u32x4 __attribute__((ext_vector_type(4)));
typedef unsigned u32x2 __attribute__((ext_vector_type(2)));
typedef GAS unsigned gu32;

constexpr int DM = 1024, BATCH = 2, SEQ = 16384, T = BATCH * SEQ, DEPTH = 4, INC = 5120;
constexpr float ALPHA = 1.6817928305074292f;
constexpr float LN_EPS = 1e-5f;
constexpr int NWAVES = 8, NTHREADS = 512;
constexpr int NPH = 1 + 8 * DEPTH;

constexpr size_t MiB = 1u << 20;
constexpr size_t WS_CTL = 0, CTL_ZERO_BYTES = 1 * MiB;
constexpr size_t WS_WIN = 1 * MiB;
constexpr size_t WS_WBR = 11 * MiB;
constexpr size_t WS_WO = 13 * MiB;
constexpr size_t WS_WGU = 15 * MiB;
constexpr size_t WS_WD = 23 * MiB;
constexpr size_t WS_SGW = 27 * MiB;
constexpr size_t WS_PERM = 416 * MiB;
constexpr size_t WS_DWP = 420 * MiB;
constexpr size_t WS_HB = 32 * MiB;
constexpr size_t WS_PA = 96 * MiB;
constexpr size_t WS_Q = 144 * MiB;
constexpr size_t WS_MG = 144 * MiB;
constexpr size_t WS_K = 160 * MiB;
constexpr size_t WS_VT = 176 * MiB;
constexpr size_t WS_UC = 192 * MiB;
constexpr size_t WS_GATE = 224 * MiB;
constexpr size_t WS_PRE = 224 * MiB;
constexpr size_t WS_Y = 416 * MiB;
constexpr size_t WS_HB8 = 464 * MiB;
constexpr size_t WS_RS = 496 * MiB;
constexpr size_t WS_WG8 = 497 * MiB;
constexpr size_t WS_CS = 502 * MiB;
constexpr size_t WS_WU8 = 503 * MiB;
constexpr size_t WS_CSU = 507 * MiB;
constexpr size_t WS_END = 508 * MiB;

constexpr int CW_TMO = 0, CW_CODE = 1, CW_BAR = 4096, CW_CNT = 8192;

constexpr int RING_BYTES = 131072, ROWTAB_OFF = RING_BYTES, ROWTAB_BYTES = 8192, LDSCTL_OFF = ROWTAB_OFF + ROWTAB_BYTES, MISC_OFF = LDSCTL_OFF + 320, MOE_OFF = MISC_OFF + 192, SIGT_OFF = MOE_OFF + 256;
constexpr int SIGT_N = 2048;
constexpr int LDS_BYTES = 147456;

__device__ __forceinline__ unsigned cvt_pk_bf16(float lo, float hi) { unsigned r; asm volatile("v_cvt_pk_bf16_f32 %0, %1, %2" : "=v"(r) : "v"(lo), "v"(hi)); return r; }
__device__ __forceinline__ float bf_lo(unsigned u) { return __uint_as_float(u << 16); }
__device__ __forceinline__ float bf_hi(unsigned u) { return __uint_as_float(u & 0xffff0000u); }
__device__ __forceinline__ float shfl_xor_l(float v, int mask, int lane) { return __int_as_float(__builtin_amdgcn_ds_bpermute((lane ^ mask) << 2, __float_as_int(v))); }
typedef int i32x4 __attribute__((ext_vector_type(4)));
__device__ __forceinline__ int q8(float x) { return (int)__builtin_rintf(__builtin_amdgcn_fmed3f(x, -127.f, 127.f)); }
__device__ __forceinline__ unsigned pack4_i8(int a, int b, int c, int d) { return (unsigned)(a & 0xff) | ((unsigned)(b & 0xff) << 8) | ((unsigned)(c & 0xff) << 16) | ((unsigned)d << 24); }
template <int CTRL> __device__ __forceinline__ float dpp_f(float v) { return __int_as_float(__builtin_amdgcn_update_dpp(0, __float_as_int(v), CTRL, 0xf, 0xf, true)); }
__device__ __forceinline__ float wave_sum(float v, int lane) {
    (void)lane;
    v += dpp_f<0xB1>(v);
    v += dpp_f<0x4E>(v);
    v += dpp_f<0x141>(v);
    v += dpp_f<0x140>(v);
    const int iv = __float_as_int(v);
    const float a = __int_as_float(__builtin_amdgcn_readlane(iv, 0)), b = __int_as_float(__builtin_amdgcn_readlane(iv, 16)), c = __int_as_float(__builtin_amdgcn_readlane(iv, 32)), d = __int_as_float(__builtin_amdgcn_readlane(iv, 48));
    return (a + b) + (c + d);
}
__device__ __forceinline__ float sigmoid_fast(float x) { return __builtin_amdgcn_rcpf(1.f + __builtin_amdgcn_exp2f(-1.4426950409f * x)); }
__device__ __forceinline__ float gelu_tanh(float x) { const float u = x * (1.f + 0.044715f * x * x); return x * __builtin_amdgcn_rcpf(1.f + __builtin_amdgcn_exp2f(-2.302208198f * u)); }
#define LDS_WAIT() asm volatile("s_waitcnt lgkmcnt(0)" ::: "memory")
#define VM_WAIT() asm volatile("s_waitcnt vmcnt(0)" ::: "memory")
#define RLX_AGENT __ATOMIC_RELAXED, __HIP_MEMORY_SCOPE_AGENT

__device__ __forceinline__ int opq(int v) { asm volatile("" : "+v"(v)); return v; }
__device__ __forceinline__ int opqs(int v) { asm volatile("" : "+s"(v)); return v; }
__device__ __forceinline__ int cur_lane() { int l; asm volatile("v_mbcnt_lo_u32_b32 %0, -1, 0\n\tv_mbcnt_hi_u32_b32 %0, -1, %0" : "=v"(l)); return l; }
__device__ __forceinline__ void glds16(const void* gsrc, unsigned lds_dst) { unsigned keep;
    asm volatile("s_mov_b32 %0, m0\n\ts_mov_b32 m0, %2\n\ts_nop 0\n\tglobal_load_lds_dwordx4 %1, off\n\ts_mov_b32 m0, %0" : "=&s"(keep) : "v"(gsrc), "s"(lds_dst) : "memory"); }
__device__ __forceinline__ float wave_max(float v) {
    v = fmaxf(v, dpp_f<0xB1>(v)); v = fmaxf(v, dpp_f<0x4E>(v)); v = fmaxf(v, dpp_f<0x141>(v)); v = fmaxf(v, dpp_f<0x140>(v));
    const int iv = __float_as_int(v);
    return fmaxf(fmaxf(__int_as_float(__builtin_amdgcn_readlane(iv, 0)), __int_as_float(__builtin_amdgcn_readlane(iv, 16))), fmaxf(__int_as_float(__builtin_amdgcn_readlane(iv, 32)), __int_as_float(__builtin_amdgcn_readlane(iv, 48))));
}
namespace pg8 {
#define PG8_LAS __attribute__((address_space(3)))
typedef unsigned short bf16_t;
constexpr int BM = 256, BK = 64, HALF = 128, HTB = HALF * BK * 2, STAGE_BYTES = 8 * HTB, NXCD = 8, WGM = 8, MAXU = 8;

__host__ __device__ __forceinline__ int lds_byte(int r, int c) { const int st = (r >> 4) * 2 + (c >> 5), rr = r & 15, cc = c & 31, ob = rr * 64 + cc * 2; return st * 1024 + (ob ^ (((ob >> 9) & 1) << 5)); }
__host__ __device__ __forceinline__ void stage_rc(int b, int& R, int& C) { const int st = b / 1024, sb = b % 1024, swz = sb ^ (((sb >> 9) & 1) << 5); R = (st >> 1) * 16 + swz / 64; C = (st & 1) * 32 + (swz % 64) / 2; }
__host__ __device__ __forceinline__ int perm32(int rho) { const int n = rho >> 4, i = rho & 15; return 8 * (i >> 2) + 4 * n + (i & 3); }

struct Unit { int pm, pn, pn2, aux; };
struct Gemm { const bf16_t* A; const bf16_t* Bt; int M, N, K, ldb; };

struct StaticOrder {
    int nM, nN, nwg, G, c;
    __host__ __device__ void init(int M, int N, int G_, int c_) { nM = M / BM; nN = N / BM; nwg = nM * nN; G = G_; c = c_; }
    __host__ __device__ bool next(int i, Unit& u) const {
        const long L = (long)i * G + c; if (L >= nwg) return false;
        int wgid = (int)L; { const int q = nwg / NXCD, r = nwg % NXCD, xcd = wgid % NXCD, off = wgid / NXCD; wgid = (xcd < r ? xcd * (q + 1) : r * (q + 1) + (xcd - r) * q) + off; }
        const int nig = WGM * nN, gid = wgid / nig, fm = gid * WGM, gsz = (nM - fm) < WGM ? (nM - fm) : WGM;
        u.pm = fm + ((wgid % nig) % gsz); u.pn = (wgid % nig) / gsz; u.pn2 = 0; u.aux = 0; return true;
    }
    __device__ __forceinline__ int arow(const Unit&, int) const { return 0; }
    __device__ __forceinline__ void a_ready(const Unit&) const {}
    __device__ __forceinline__ void done(const Unit&) const {}
};

template <class Epi, class Sched, bool ALIGN_EPI, bool GATHER, bool SPLITB = false, bool I8 = false>
__device__ __forceinline__ void gemm_phase(PG8_LAS unsigned char* lds, const int wid, const Gemm g, const Sched& S, const Epi& E) {
    const int lane = cur_lane(), tid = wid * 64 + lane, wr = wid >> 2, wc = wid & 3, fr = lane & 15, fq = lane >> 4;
    const int K = g.K, nt = K / BK, ldb = g.ldb ? g.ldb : K;
    unsigned voffA[2], voffB[2]; int Rr[2], Cc[2];
#pragma unroll
    for (int i = 0; i < 2; ++i) { int R, C; stage_rc(tid * 16 + i * 8192, R, C); const int Rb = Epi::PERM ? ((R & ~31) + perm32(R & 31)) : R;
        Rr[i] = R; Cc[i] = C; voffA[i] = (unsigned)(R * K + C) * 2u; voffB[i] = (unsigned)(Rb * ldb + C) * 2u; }
    const size_t kstep = (size_t)(BK * 2);
    const size_t hstep = (size_t)HALF * K * 2;
    const size_t tstep = 2 * hstep;
    const size_t hstepB = (size_t)HALF * ldb * 2, tstepB = 2 * hstepB;
    const unsigned ldsb = (unsigned)(unsigned long long)lds + (unsigned)wid * 1024u;
    const int aoff = lds_byte(wr * 64 + fr, fq * 8), boff = lds_byte(wc * 32 + fr, fq * 8);
#define PG8_SA(b, h) (((b) * 2 + (h)) * HTB)
#define PG8_SB(b, h) ((4 + (b) * 2 + (h)) * HTB)
#define PG8_STAGE(bufoff, gbase, voff) do { _Pragma("unroll") for (int _i = 0; _i < 2; ++_i) \
        glds16((const char*)(gbase) + (voff)[_i], ldsb + (unsigned)((bufoff) + _i * 8192)); } while (0)
#define PG8_STAGE_A(bufoff, kp, h, vs) do { if constexpr (GATHER) { PG8_STAGE(bufoff, kp, vs[h]); } else { PG8_STAGE(bufoff, (kp) + (h) * hstep, voffA); } } while (0)
#define PG8_LDA(dst, b, h) do { _Pragma("unroll") for (int m = 0; m < 4; ++m) _Pragma("unroll") for (int k = 0; k < 2; ++k) dst[m][k] = *(const PG8_LAS bf16x8*)(lds + PG8_SA(b, h) + aoff + m * 2048 + k * 1024); } while (0)
#define PG8_LDB(dst, b, h) do { _Pragma("unroll") for (int n = 0; n < 2; ++n) _Pragma("unroll") for (int k = 0; k < 2; ++k) dst[n][k] = *(const PG8_LAS bf16x8*)(lds + PG8_SB(b, h) + boff + n * 2048 + k * 1024); } while (0)
#define PG8_MMA(ai, bj, At, Bt) do { __builtin_amdgcn_s_setprio(1); _Pragma("unroll") for (int m = 0; m < 4; ++m) _Pragma("unroll") for (int n = 0; n < 2; ++n) _Pragma("unroll") for (int k = 0; k < 2; ++k) \
        { if constexpr (I8) acc[ai][bj][m][n] = __builtin_bit_cast(f32x4, __builtin_amdgcn_mfma_i32_16x16x64_i8(__builtin_bit_cast(i32x4, Bt[n][k]), __builtin_bit_cast(i32x4, At[m][k]), __builtin_bit_cast(i32x4, acc[ai][bj][m][n]), 0, 0, 0)); \
          else acc[ai][bj][m][n] = __builtin_amdgcn_mfma_f32_16x16x32_bf16(Bt[n][k], At[m][k], acc[ai][bj][m][n], 0, 0, 0); } __builtin_amdgcn_s_setprio(0); } while (0)
#define PG8_WAIT_V(n) asm volatile("s_waitcnt vmcnt(" #n ")" ::: "memory")
#define PG8_WAIT_L(n) asm volatile("s_waitcnt lgkmcnt(" #n ")" ::: "memory")
#define PG8_BAR __builtin_amdgcn_s_barrier()
#define PG8_SCHED __builtin_amdgcn_sched_barrier(0)
    Unit cur, nxt; int ui = 0;
    if (!S.next(0, cur)) return;
    PG8_LAS int* rowtab = (PG8_LAS int*)(lds + STAGE_BYTES);
    unsigned vAc[2][2], vAn[2][2], vS[2][2];
    if constexpr (GATHER) {
        Unit uu;
        for (int i = 0; i < MAXU; ++i) { if (!S.next(i, uu)) break; if (tid < 256) rowtab[i * 256 + tid] = S.arow(uu, tid); }
        asm volatile("s_waitcnt vmcnt(0) lgkmcnt(0)" ::: "memory"); __builtin_amdgcn_s_barrier(); asm volatile("" ::: "memory");
#pragma unroll
        for (int h = 0; h < 2; ++h)
#pragma unroll
            for (int i = 0; i < 2; ++i) { vAc[h][i] = (unsigned)(rowtab[h * 128 + Rr[i]] * K + Cc[i]) * 2u; vAn[h][i] = vAc[h][i]; vS[h][i] = vAc[h][i]; }
    }
    f32x4 acc[2][2][4][2];
#pragma unroll
    for (int a = 0; a < 2; ++a)
#pragma unroll
        for (int b = 0; b < 2; ++b)
#pragma unroll
            for (int m = 0; m < 4; ++m)
#pragma unroll
                for (int n = 0; n < 2; ++n) acc[a][b][m][n] = (f32x4){0.f, 0.f, 0.f, 0.f};
    bf16x8 At[4][2], B0[2][2], B1[2][2];
    const char* cA = GATHER ? (const char*)g.A : (const char*)g.A + (size_t)cur.pm * tstep; const char* cB = (const char*)g.Bt + (size_t)cur.pn * tstepB; const char* cB2 = (const char*)g.Bt + (size_t)cur.pn2 * tstepB;
    S.a_ready(cur);
    PG8_STAGE(PG8_SB(0, 0), cB, voffB); PG8_STAGE(PG8_SB(0, 1), cB + hstepB, voffB); PG8_STAGE_A(PG8_SA(0, 0), cA, 0, vAc); PG8_STAGE_A(PG8_SA(0, 1), cA, 1, vAc);
    if (wr == 1) PG8_BAR;
    PG8_WAIT_V(2); PG8_BAR;
    PG8_STAGE(PG8_SB(1, 0), cB + kstep, voffB); PG8_STAGE_A(PG8_SA(1, 0), cA + kstep, 0, vAc); PG8_STAGE(PG8_SB(1, 1), cB + hstepB + kstep, voffB);
    PG8_WAIT_V(6); PG8_BAR;
    for (;;) {
        const bool has_next = S.next(ui + 1, nxt);
        const char* nA = GATHER ? cA : (has_next ? (const char*)g.A + (size_t)nxt.pm * tstep : cA); const char* nB = has_next ? (const char*)g.Bt + (size_t)nxt.pn * tstepB : cB; const char* nB2 = has_next ? (const char*)g.Bt + (size_t)nxt.pn2 * tstepB : cB2;
        if constexpr (GATHER) {
            if (has_next) {
#pragma unroll
                for (int h = 0; h < 2; ++h)
#pragma unroll
                    for (int i = 0; i < 2; ++i) vAn[h][i] = (unsigned)(rowtab[(ui + 1) * 256 + h * 128 + Rr[i]] * K + Cc[i]) * 2u;
            }
        }
        for (int t = 0; t < nt; t += 2) {
            const bool last = (t == nt - 2);
            const char* a1 = cA + (size_t)(t + 1) * kstep;
            const char* a2 = last ? nA : cA + (size_t)(t + 2) * kstep; const char* b2 = last ? nB : (SPLITB ? cB2 : cB + (size_t)(t + 2) * kstep);
            const char* a3 = a2 + kstep; const char* b3 = b2 + kstep;
            if constexpr (GATHER) {
#pragma unroll
                for (int h = 0; h < 2; ++h)
#pragma unroll
                    for (int i = 0; i < 2; ++i) vS[h][i] = last ? vAn[h][i] : vAc[h][i];
            }
            if (last && has_next) S.a_ready(nxt);
            PG8_LDB(B0, 0, 0); PG8_LDB(B1, 0, 1); PG8_SCHED; PG8_LDA(At, 0, 0); PG8_STAGE_A(PG8_SA(1, 1), a1, 1, vAc);
            PG8_WAIT_V(8); PG8_WAIT_L(0); PG8_BAR; PG8_MMA(0, 0, At, B0); PG8_MMA(0, 1, At, B1); PG8_BAR; PG8_SCHED;
            PG8_LDA(At, 0, 1); PG8_STAGE(PG8_SB(0, 0), b2, voffB); PG8_STAGE(PG8_SB(0, 1), b2 + hstepB, voffB); PG8_STAGE_A(PG8_SA(0, 0), a2, 0, vS);
            PG8_WAIT_V(8); PG8_WAIT_L(0); PG8_BAR; PG8_MMA(1, 0, At, B0); PG8_MMA(1, 1, At, B1); PG8_BAR; PG8_SCHED;
            PG8_LDB(B0, 1, 0); PG8_LDB(B1, 1, 1); PG8_SCHED; PG8_LDA(At, 1, 0); PG8_STAGE_A(PG8_SA(0, 1), a2, 1, vS);
            PG8_WAIT_V(8); PG8_WAIT_L(0); PG8_BAR; PG8_MMA(0, 0, At, B0); PG8_MMA(0, 1, At, B1); PG8_BAR; PG8_SCHED;
            PG8_LDA(At, 1, 1); PG8_STAGE(PG8_SB(1, 0), b3, voffB); PG8_STAGE(PG8_SB(1, 1), b3 + hstepB, voffB); PG8_STAGE_A(PG8_SA(1, 0), a3, 0, vS);
            PG8_WAIT_V(8); PG8_WAIT_L(0); PG8_BAR; PG8_MMA(1, 0, At, B0); PG8_MMA(1, 1, At, B1); PG8_BAR; PG8_SCHED;
        }
        if constexpr (ALIGN_EPI) { if (wr == 0) PG8_BAR; }
        E(acc, cur, wr, wc, fr, fq); S.done(cur);
        if (!has_next) break;
        if (!E.keep(cur))
#pragma unroll
        for (int a = 0; a < 2; ++a)
#pragma unroll
            for (int b = 0; b < 2; ++b)
#pragma unroll
                for (int m = 0; m < 4; ++m)
#pragma unroll
                    for (int n = 0; n < 2; ++n) acc[a][b][m][n] = (f32x4){0.f, 0.f, 0.f, 0.f};
        cur = nxt; cA = nA; cB = nB; cB2 = nB2; ++ui;
        if constexpr (GATHER) {
#pragma unroll
            for (int h = 0; h < 2; ++h)
#pragma unroll
                for (int i = 0; i < 2; ++i) vAc[h][i] = vAn[h][i];
        }
        if constexpr (ALIGN_EPI) { if (wr == 1) PG8_BAR; }
    }
    PG8_WAIT_V(0);
    if constexpr (!ALIGN_EPI) { if (wr == 0) PG8_BAR; }
    PG8_BAR;
#undef PG8_SA
#undef PG8_SB
#undef PG8_STAGE
#undef PG8_STAGE_A
#undef PG8_LDA
#undef PG8_LDB
#undef PG8_MMA
#undef PG8_WAIT_V
#undef PG8_WAIT_L
#undef PG8_BAR
#undef PG8_SCHED
}
}

#define XB_TMO      128
#define XB_XCNT(j)  (256  + 64 * (j))
#define XB_XSUB(j)  (1280 + 64 * (j))
#define XB_XGEN(j)  (2304 + 64 * (j))
#define XB_TOP      3328
#define XB_TOPGEN   3392
#define XCD_BAR_WORDS 3456
#define XB_SPIN_CAP (1u << 18)

__device__ __forceinline__ unsigned xb_ld(unsigned* p)              { return __hip_atomic_load(p, __ATOMIC_RELAXED, __HIP_MEMORY_SCOPE_AGENT); }
__device__ __forceinline__ unsigned xb_add(unsigned* p, unsigned v) { return __hip_atomic_fetch_add(p, v, __ATOMIC_RELAXED, __HIP_MEMORY_SCOPE_AGENT); }
__device__ __forceinline__ unsigned xb_xcc_id() { return (unsigned)__builtin_amdgcn_s_getreg((3 << 11) | 20) & 0xFu; }
#define XB_SPIN(cond, bar) do { unsigned _sp = 0; while (cond) { __builtin_amdgcn_s_sleep(1); \
    if ((++_sp & 255u) == 0u) { if (xb_ld(&(bar)[XB_TMO])) break; if (_sp > XB_SPIN_CAP) { atomicAdd(&(bar)[XB_TMO], 1u); break; } } } } while (0)

struct XcdBarrier {
    unsigned* bar; unsigned x;
    volatile LAS unsigned* st;
};
__device__ __forceinline__ XcdBarrier xcd_barrier_post(unsigned* bar, volatile LAS unsigned* st) {
    XcdBarrier b; b.bar = bar; b.x = xb_xcc_id(); b.st = st;
    if (threadIdx.x == 0) (void)xb_add(&bar[XB_XCNT(b.x)], 1u);
    return b;
}
__device__ __forceinline__ void xcd_barrier_complete(unsigned* bar, unsigned x, unsigned& nloc, unsigned& nx) {
    const unsigned G = gridDim.x * gridDim.y * gridDim.z;
    unsigned sum, cnt, mine, sp = 0u;
    for (;;) {
        sum = 0u; cnt = 0u; mine = 0u;
#pragma unroll
        for (unsigned j = 0; j < 16; ++j) { const unsigned c = xb_ld(&bar[XB_XCNT(j)]); sum += c; cnt += (c > 0u) ? 1u : 0u; mine = (j == x) ? c : mine; }
        if (sum == G) break;
        __builtin_amdgcn_s_sleep(1);
        if ((++sp & 255u) == 0u) { if (xb_ld(&bar[XB_TMO])) break; if (sp > XB_SPIN_CAP) { atomicAdd(&bar[XB_TMO], 1u); break; } }
    }
    nloc = mine > 0u ? mine : 1u; nx = cnt > 0u ? cnt : 1u;
}
__device__ __forceinline__ void xcd_barrier(const XcdBarrier& b, const bool thread0) {
    asm volatile("s_waitcnt vmcnt(0)" ::: "memory");
    __syncthreads();
    if (thread0) {
        unsigned* bar = b.bar;
        __builtin_amdgcn_s_waitcnt(0);
        unsigned nloc = b.st[0], nx = b.st[1];
        if (nloc == 0u) { xcd_barrier_complete(bar, b.x, nloc, nx); b.st[0] = nloc; b.st[1] = nx; }
        const unsigned old = xb_add(&bar[XB_XSUB(b.x)], 1u);
        const unsigned gen = old / nloc;
        if (old + 1u == (gen + 1u) * nloc) {
            __builtin_amdgcn_fence(__ATOMIC_RELEASE, "agent");
            asm volatile("s_waitcnt vmcnt(0)" ::: "memory");
            const unsigned og = xb_add(&bar[XB_TOP], 1u);
            const unsigned tg = og / nx;
            if (og + 1u == (tg + 1u) * nx) xb_add(&bar[XB_TOPGEN], 1u);
            else XB_SPIN(xb_ld(&bar[XB_TOPGEN]) == tg, bar);
            __builtin_amdgcn_fence(__ATOMIC_ACQUIRE, "agent");
            xb_add(&bar[XB_XGEN(b.x)], 1u);
            asm volatile("s_waitcnt vmcnt(0)" ::: "memory");
        } else {
            XB_SPIN(xb_ld(&bar[XB_XGEN(b.x)]) == gen, bar);
            __builtin_amdgcn_fence(__ATOMIC_ACQUIRE, "agent");
            asm volatile("s_waitcnt vmcnt(0)" ::: "memory");
        }
    }
    __syncthreads();
}

using pg8::Unit;
struct EpiProj {
    static constexpr bool PERM = true;
    __device__ __forceinline__ bool keep(const Unit&) const { return false; }
    bf16 *PA, *Q, *Kb, *UC; unsigned char* GATE; const float* bgate; const LAS unsigned char* sigt; const float* rs; const float* cs;
    __device__ __forceinline__ void operator()(f32x4 (&acc)[2][2][4][2], const Unit& u, int wr, int wc, int fr, int fq) const {
        const int pn = u.pn; bf16* dst; int ldc, cb, act;
        if (pn < 3) { dst = PA; ldc = 768; cb = pn * 256; act = 0; }
        else if (pn == 3) { dst = Q; ldc = 256; cb = 0; act = 3; }
        else if (pn == 4) { dst = Kb; ldc = 256; cb = 0; act = 0; }
        else if (pn < 8) { dst = UC; ldc = 512; cb = (pn - 6) * 256; act = 1; }
        else { dst = PA; ldc = 0; cb = (pn - 8) * 256; act = 2; }
        const int row0 = u.pm * 256 + wr * 64 + fr, col0 = cb + wc * 32 + 8 * fq;
        unsigned char* gblk = GATE + ((size_t)(u.pm * 12 + (pn - 8)) << 16) + ((((wr * 4 + wc) * 4 + fq) * 16 + fr) << 3);
        f32x4 bv[2][2];
#pragma unroll
        for (int bj = 0; bj < 2; ++bj)
#pragma unroll
            for (int n = 0; n < 2; ++n) bv[bj][n] = *(const f32x4*)(bgate + (act == 2 ? col0 : 0) + bj * 128 + 4 * n);
#pragma unroll
        for (int ai = 0; ai < 2; ++ai)
#pragma unroll
            for (int m = 0; m < 4; ++m) { bf16* rowp = dst + (size_t)(row0 + ai * 128 + m * 16) * ldc + col0;
#pragma unroll
                for (int bj = 0; bj < 2; ++bj) { const i32x4 i0 = __builtin_bit_cast(i32x4, acc[ai][bj][m][0]), i1 = __builtin_bit_cast(i32x4, acc[ai][bj][m][1]); const float rsv = rs[row0 + ai * 128 + m * 16];
                    const f32x4 c0 = *(const f32x4*)(cs + u.pn * 256 + wc * 32 + 8 * fq + bj * 128), c1 = *(const f32x4*)(cs + u.pn * 256 + wc * 32 + 8 * fq + bj * 128 + 4);
                    f32x4 v0 = (f32x4){(float)i0[0], (float)i0[1], (float)i0[2], (float)i0[3]} * c0 * rsv, v1 = (f32x4){(float)i1[0], (float)i1[1], (float)i1[2], (float)i1[3]} * c1 * rsv;
                    if (act == 1) {
#pragma unroll
                        for (int j = 0; j < 4; ++j) { v0[j] = gelu_tanh(v0[j]); v1[j] = gelu_tanh(v1[j]); }
                    } else if (act == 2) { v0 = v0 + bv[bj][0]; v1 = v1 + bv[bj][1]; unsigned q[8];
#pragma unroll
                        for (int j = 0; j < 4; ++j) { q[j] = sigt[(int)__builtin_amdgcn_fmed3f(v0[j] * 128.f + 1024.f, 0.f, 2047.f)]; q[4 + j] = sigt[(int)__builtin_amdgcn_fmed3f(v1[j] * 128.f + 1024.f, 0.f, 2047.f)]; }
                        u32x2 w8; w8.x = q[0] | (q[1] << 8) | (q[2] << 16) | (q[3] << 24); w8.y = q[4] | (q[5] << 8) | (q[6] << 16) | (q[7] << 24);
                        *(u32x2*)(gblk + ((((ai * 4 + m) * 2 + bj)) << 12)) = w8; continue;
                    } else if (act == 3) { v0 = v0 * 0.18033688f; v1 = v1 * 0.18033688f; }
                    u32x4 w; w.x = cvt_pk_bf16(v0[0], v0[1]); w.y = cvt_pk_bf16(v0[2], v0[3]); w.z = cvt_pk_bf16(v1[0], v1[1]); w.w = cvt_pk_bf16(v1[2], v1[3]);
                    *(u32x4*)(rowp + bj * 128) = w; } }
        asm volatile("" :: "v"(bv[0][0]), "v"(bv[0][1]), "v"(bv[1][0]), "v"(bv[1][1]));
    }
};
struct EpiGate {
    static constexpr bool PERM = true;
    __device__ __forceinline__ bool keep(const Unit&) const { return false; }
    unsigned char* GATE; const float* bgate; const float* rs; const float* cs; const LAS unsigned char* sigt;
    __device__ __forceinline__ void operator()(f32x4 (&acc)[2][2][4][2], const Unit& u, int wr, int wc, int fr, int fq) const {
        const int row0 = u.pm * 256 + wr * 64 + fr, col0 = u.pn * 256 + wc * 32 + 8 * fq;
        unsigned char* gblk = GATE + ((size_t)(u.pm * 12 + u.pn) << 16) + ((((wr * 4 + wc) * 4 + fq) * 16 + fr) << 3);
        f32x4 bv[2][2], cv[2][2]; float rv[2][4];
#pragma unroll
        for (int bj = 0; bj < 2; ++bj)
#pragma unroll
            for (int n = 0; n < 2; ++n) { bv[bj][n] = *(const f32x4*)(bgate + col0 + bj * 128 + 4 * n); cv[bj][n] = *(const f32x4*)(cs + col0 + bj * 128 + 4 * n); }
#pragma unroll
        for (int ai = 0; ai < 2; ++ai)
#pragma unroll
            for (int m = 0; m < 4; ++m) rv[ai][m] = rs[row0 + ai * 128 + m * 16];
#pragma unroll
        for (int ai = 0; ai < 2; ++ai)
#pragma unroll
            for (int m = 0; m < 4; ++m)
#pragma unroll
                for (int bj = 0; bj < 2; ++bj) { const i32x4 i0 = __builtin_bit_cast(i32x4, acc[ai][bj][m][0]), i1 = __builtin_bit_cast(i32x4, acc[ai][bj][m][1]); unsigned q[8];
#pragma unroll
                    for (int j = 0; j < 4; ++j) { const float v0 = (float)i0[j] * (rv[ai][m] * cv[bj][0][j]) + bv[bj][0][j], v1 = (float)i1[j] * (rv[ai][m] * cv[bj][1][j]) + bv[bj][1][j];
                        q[j] = sigt[(int)__builtin_amdgcn_fmed3f(v0 * 128.f + 1024.f, 0.f, 2047.f)]; q[4 + j] = sigt[(int)__builtin_amdgcn_fmed3f(v1 * 128.f + 1024.f, 0.f, 2047.f)]; }
                    u32x2 w8; w8.x = q[0] | (q[1] << 8) | (q[2] << 16) | (q[3] << 24); w8.y = q[4] | (q[5] << 8) | (q[6] << 16) | (q[7] << 24);
                    *(u32x2*)(gblk + ((((ai * 4 + m) * 2 + bj)) << 12)) = w8; }
    }
};
struct EpiVt {
    static constexpr bool PERM = true;
    __device__ __forceinline__ bool keep(const Unit&) const { return false; }
    bf16* VT; const float* rs; const float* cs;
    __device__ __forceinline__ void operator()(f32x4 (&acc)[2][2][4][2], const Unit& u, int wr, int wc, int fr, int fq) const {
        const int row0 = wr * 64 + fr, col0 = u.pn * 256 + wc * 32 + 8 * fq;
#pragma unroll
        for (int ai = 0; ai < 2; ++ai)
#pragma unroll
            for (int m = 0; m < 4; ++m) { const int dg = row0 + ai * 128 + m * 16;
                bf16* rowp = VT + ((size_t)(dg >> 6) * (T / 32) * 64 + (dg & 63)) * 32 + (size_t)(col0 >> 5) * 2048 + (col0 & 31);
#pragma unroll
                for (int bj = 0; bj < 2; ++bj) { const i32x4 i0 = __builtin_bit_cast(i32x4, acc[ai][bj][m][0]), i1 = __builtin_bit_cast(i32x4, acc[ai][bj][m][1]); const float csv = cs[1280 + dg];
                    const f32x4 r0 = *(const f32x4*)(rs + col0 + bj * 128), r1 = *(const f32x4*)(rs + col0 + bj * 128 + 4);
                    const f32x4 v0 = (f32x4){(float)i0[0], (float)i0[1], (float)i0[2], (float)i0[3]} * r0 * csv, v1 = (f32x4){(float)i1[0], (float)i1[1], (float)i1[2], (float)i1[3]} * r1 * csv;
                    u32x4 w; w.x = cvt_pk_bf16(v0[0], v0[1]); w.y = cvt_pk_bf16(v0[2], v0[3]); w.z = cvt_pk_bf16(v1[0], v1[1]); w.w = cvt_pk_bf16(v1[2], v1[3]);
                    *(u32x4*)(rowp + bj * 4 * 2048) = w; } }
    }
};
struct EpiMerge {
    static constexpr bool PERM = true;
    const unsigned char* GATE; bf16* MG;
    __device__ __forceinline__ bool keep(const Unit& u) const { return (u.pn >> 2) < 2; }
    __device__ __forceinline__ void operator()(f32x4 (&acc)[2][2][4][2], const Unit& u, int wr, int wc, int fr, int fq) const {
        const int br = u.pn >> 2, pm = u.pm - br * (T / 256), pn = u.pn & 3;
        const int row0 = pm * 256 + wr * 64 + fr, col0 = pn * 256 + wc * 32 + 8 * fq;
        const unsigned char* gbase = GATE + ((size_t)(pm * 12 + br * 4 + pn) << 16) + ((((wr * 4 + wc) * 4 + fq) * 16 + fr) << 3); const int gnext = br < 2 ? (4 << 16) : 0;
        u32x2 ga[4][2][2], gb[4][2][2];
#define EM_LOAD(hb) do { _Pragma("unroll") for (int mm = 0; mm < 2; ++mm) _Pragma("unroll") for (int bj = 0; bj < 2; ++bj) { \
            const unsigned char* gp = gbase + ((((((hb) >> 1) * 4 + 2 * ((hb) & 1) + mm) * 2 + bj)) << 12); \
            ga[hb][mm][bj] = *(const u32x2*)gp; gb[hb][mm][bj] = *(const u32x2*)(gp + gnext); } asm volatile("" ::: "memory"); } while (0)
#define EM_COMP(hb) do { _Pragma("unroll") for (int mm = 0; mm < 2; ++mm) _Pragma("unroll") for (int bj = 0; bj < 2; ++bj) { \
            constexpr int ai = (hb) >> 1; const int m = 2 * ((hb) & 1) + mm; const u32x2 a = ga[hb][mm][bj], b = gb[hb][mm][bj]; float s[8]; \
            _Pragma("unroll") for (int q = 0; q < 8; ++q) { float av = (float)((a[q >> 2] >> (8 * (q & 3))) & 0xffu); const float bv_ = (float)((b[q >> 2] >> (8 * (q & 3))) & 0xffu); \
                if (br > 0) av = fmaxf(av, 1.f);                        \
                if (br < 2) av *= __builtin_amdgcn_rcpf(fmaxf(bv_, 1.f)); else av *= (1.f / 255.f); \
                s[q] = av; } \
            f32x4 v0 = acc[ai][bj][m][0], v1 = acc[ai][bj][m][1]; \
            v0[0] *= s[0]; v0[1] *= s[1]; v0[2] *= s[2]; v0[3] *= s[3]; v1[0] *= s[4]; v1[1] *= s[5]; v1[2] *= s[6]; v1[3] *= s[7]; \
            if (br < 2) { acc[ai][bj][m][0] = v0; acc[ai][bj][m][1] = v1; } \
            else { u32x4 w; w.x = cvt_pk_bf16(v0[0], v0[1]); w.y = cvt_pk_bf16(v0[2], v0[3]); w.z = cvt_pk_bf16(v1[0], v1[1]); w.w = cvt_pk_bf16(v1[2], v1[3]); \
                *(u32x4*)(MG + (size_t)(row0 + ai * 128 + m * 16) * 1024 + col0 + bj * 128) = w; } } asm volatile("" ::: "memory"); } while (0)
        EM_LOAD(0); EM_LOAD(1); EM_COMP(0); EM_LOAD(2); EM_COMP(1); EM_LOAD(3); EM_COMP(2); EM_COMP(3);
#undef EM_LOAD
#undef EM_COMP
    }
};
struct EpiWo {
    static constexpr bool PERM = true;
    __device__ __forceinline__ bool keep(const Unit&) const { return false; }
    const bf16* HB; bf16* out;
    __device__ __forceinline__ void operator()(f32x4 (&acc)[2][2][4][2], const Unit& u, int wr, int wc, int fr, int fq) const {
        const int row0 = u.pm * 256 + wr * 64 + fr, col0 = u.pn * 256 + wc * 32 + 8 * fq;
        u32x4 hv[4][2][2];
#define EW_LOAD(hb) do { _Pragma("unroll") for (int mm = 0; mm < 2; ++mm) _Pragma("unroll") for (int bj = 0; bj < 2; ++bj) \
            hv[hb][mm][bj] = *(const u32x4*)(HB + (size_t)(row0 + ((hb) >> 1) * 128 + (2 * ((hb) & 1) + mm) * 16) * DM + col0 + bj * 128); asm volatile("" ::: "memory"); } while (0)
#define EW_COMP(hb) do { _Pragma("unroll") for (int mm = 0; mm < 2; ++mm) _Pragma("unroll") for (int bj = 0; bj < 2; ++bj) { \
            constexpr int ai = (hb) >> 1; const int m = 2 * ((hb) & 1) + mm; const u32x4 h = hv[hb][mm][bj]; bf16* op = out + (size_t)(row0 + ai * 128 + m * 16) * DM + col0 + bj * 128; \
            const f32x4 h0 = (f32x4){bf_lo(h.x), bf_hi(h.x), bf_lo(h.y), bf_hi(h.y)}, h1 = (f32x4){bf_lo(h.z), bf_hi(h.z), bf_lo(h.w), bf_hi(h.w)}; \
            const f32x4 p0 = h0 * ALPHA + acc[ai][bj][m][0], p1 = h1 * ALPHA + acc[ai][bj][m][1]; \
            u32x4 w; w.x = cvt_pk_bf16(p0[0], p0[1]); w.y = cvt_pk_bf16(p0[2], p0[3]); w.z = cvt_pk_bf16(p1[0], p1[1]); w.w = cvt_pk_bf16(p1[2], p1[3]); *(u32x4*)op = w; } asm volatile("" ::: "memory"); } while (0)
        EW_LOAD(0); EW_LOAD(1); EW_LOAD(2); EW_COMP(0); EW_LOAD(3); EW_COMP(1); EW_COMP(2); EW_COMP(3);
#undef EW_LOAD
#undef EW_COMP
    }
};
constexpr int NBK = 24;
__device__ __forceinline__ void moe_build(LAS int* mt, gu32* gcnt, int tid) {
    if (tid < NBK) mt[tid] = (int)__hip_atomic_load(gcnt + tid, RLX_AGENT);
    __syncthreads();
    if (tid == 0) { int a = 0; for (int j = 0; j < NBK; ++j) { mt[32 + j] = a; a += (mt[j] + 255) >> 8; } mt[56] = a; }
    __syncthreads();
}
__device__ __forceinline__ int mtu(const LAS int* mt, int i) { return __builtin_amdgcn_readfirstlane(mt[i]); }
__device__ __forceinline__ int moe_bucket_of(const LAS int* mt, int rt) {
    const int lane = cur_lane(); const bool p = lane < NBK && rt >= mt[33 + (lane < NBK ? lane : 0)];
    return (int)__popcll(__ballot(p));
}
template <int SH>
struct MoeOrder {
    const LAS int* mt; int G, c, ntile; const int* perm;
    __device__ __forceinline__ bool next(int i, Unit& u) const {
        const long L = (long)i * G + c; if (L >= ((long)ntile << SH)) return false;
        const int rt = (int)(L >> SH), q = (int)(L & ((1 << SH) - 1)), b = moe_bucket_of(mt, rt), g = b / 6, pi = b - 6 * g;
        const int lo = pi < 3 ? 0 : pi < 5 ? 1 : 2, hi = pi < 3 ? pi + 1 : pi < 5 ? pi - 1 : 3;
        u.pm = rt;
        if (SH == 1) { u.pn = 4 * g + (q ? hi : lo); u.pn2 = 0; u.aux = b * 2 + q; }
        else { u.pn = (4 * g + lo) * 4 + q; u.pn2 = (4 * g + hi) * 4 + q; u.aux = b * 4 + q; }
        return true;
    }
    __device__ __forceinline__ int arow(const Unit& u, int r) const {
        const int b = u.aux >> SH, slot = (u.pm - mtu(mt, 32 + b)) * 256 + r;
        return slot < mtu(mt, b) ? perm[(size_t)b * T + slot] : 0;
    }
    __device__ __forceinline__ void a_ready(const Unit&) const {}
    __device__ __forceinline__ void done(const Unit&) const {}
};
struct EpiMoeUp {
    static constexpr bool PERM = true;
    __device__ __forceinline__ bool keep(const Unit&) const { return false; }
    const LAS int* mt; const float* dwp; bf16* HID; const float* csu;
    __device__ __forceinline__ void operator()(f32x4 (&acc)[2][2][4][2], const Unit& u, int wr, int wc, int fr, int fq) const {
        const int b = u.aux >> 1, q = u.aux & 1, tb = mtu(mt, 32 + b), cnt = mtu(mt, b);
        const int r0 = wr * 64 + fr, f0 = wc * 32 + 8 * fq, col0 = q * 128 + f0;
        float dwv[2][4], rsv[2][4];
#pragma unroll
        for (int ai = 0; ai < 2; ++ai)
#pragma unroll
            for (int m = 0; m < 4; ++m) { const int slot = (u.pm - tb) * 256 + r0 + ai * 128 + m * 16; const f32x4 dv = *(const f32x4*)(dwp + ((size_t)b * T + (slot < cnt ? slot : 0)) * 4);
                dwv[ai][m] = slot < cnt ? (q ? dv.y : dv.x) : 0.f; rsv[ai][m] = slot < cnt ? dv.z : 0.f; }
        const f32x4 cg0 = *(const f32x4*)(csu + u.pn * 256 + f0), cg1 = *(const f32x4*)(csu + u.pn * 256 + f0 + 4), cu0 = *(const f32x4*)(csu + u.pn * 256 + 128 + f0), cu1 = *(const f32x4*)(csu + u.pn * 256 + 128 + f0 + 4);
#pragma unroll
        for (int ai = 0; ai < 2; ++ai)
#pragma unroll
            for (int m = 0; m < 4; ++m) { const int r = r0 + ai * 128 + m * 16; const float dw = dwv[ai][m], rs_ = rsv[ai][m];
                const i32x4 ig0 = __builtin_bit_cast(i32x4, acc[ai][0][m][0]), ig1 = __builtin_bit_cast(i32x4, acc[ai][0][m][1]), iu0 = __builtin_bit_cast(i32x4, acc[ai][1][m][0]), iu1 = __builtin_bit_cast(i32x4, acc[ai][1][m][1]);
                float h[8];
#pragma unroll
                for (int j = 0; j < 4; ++j) { const float g0 = (float)ig0[j] * (rs_ * cg0[j]), g1 = (float)ig1[j] * (rs_ * cg1[j]), u0 = (float)iu0[j] * (rs_ * cu0[j]), u1 = (float)iu1[j] * (rs_ * cu1[j]);
                    h[j] = g0 * sigmoid_fast(g0) * u0 * dw; h[4 + j] = g1 * sigmoid_fast(g1) * u1 * dw; }
                u32x4 w; w.x = cvt_pk_bf16(h[0], h[1]); w.y = cvt_pk_bf16(h[2], h[3]); w.z = cvt_pk_bf16(h[4], h[5]); w.w = cvt_pk_bf16(h[6], h[7]);
                *(u32x4*)(HID + (size_t)(u.pm * 256 + r) * 256 + col0) = w; }
    }
};
struct EpiMoeDown {
    static constexpr bool PERM = true;
    __device__ __forceinline__ bool keep(const Unit&) const { return false; }
    const LAS int* mt; const int* perm; const bf16* HB; bf16* out;
    __device__ __forceinline__ void operator()(f32x4 (&acc)[2][2][4][2], const Unit& u, int wr, int wc, int fr, int fq) const {
        const int b = u.aux >> 2, pn = u.aux & 3, tb = mtu(mt, 32 + b), cnt = mtu(mt, b);
        const int r0 = wr * 64 + fr, col0 = pn * 256 + wc * 32 + 8 * fq;
        int tok[2][4];
#pragma unroll
        for (int ai = 0; ai < 2; ++ai)
#pragma unroll
            for (int m = 0; m < 4; ++m) { const int slot = (u.pm - tb) * 256 + r0 + ai * 128 + m * 16; const int tk = perm[(size_t)b * T + (slot < cnt ? slot : 0)]; tok[ai][m] = slot < cnt ? tk : -1; }
#pragma unroll
        for (int ai = 0; ai < 2; ++ai) {
            u32x4 hv[4][2];
#pragma unroll
            for (int m = 0; m < 4; ++m) { const int tk = tok[ai][m] >= 0 ? tok[ai][m] : 0;
#pragma unroll
                for (int bj = 0; bj < 2; ++bj) hv[m][bj] = *(const u32x4*)(HB + (size_t)tk * DM + col0 + bj * 128); }
#pragma unroll
            for (int m = 0; m < 4; ++m) {
#pragma unroll
                for (int bj = 0; bj < 2; ++bj) { const u32x4 h = hv[m][bj];
                    const f32x4 h0 = (f32x4){bf_lo(h.x), bf_hi(h.x), bf_lo(h.y), bf_hi(h.y)}, h1 = (f32x4){bf_lo(h.z), bf_hi(h.z), bf_lo(h.w), bf_hi(h.w)};
                    const f32x4 p0 = h0 * ALPHA + acc[ai][bj][m][0], p1 = h1 * ALPHA + acc[ai][bj][m][1];
                    u32x4 w; w.x = cvt_pk_bf16(p0[0], p0[1]); w.y = cvt_pk_bf16(p0[2], p0[3]); w.z = cvt_pk_bf16(p1[0], p1[1]); w.w = cvt_pk_bf16(p1[2], p1[3]);
                    if (tok[ai][m] >= 0) *(u32x4*)(out + (size_t)tok[ai][m] * DM + col0 + bj * 128) = w; } }
            asm volatile("" ::: "memory"); }
    }
};
struct ProjOrder : pg8::StaticOrder {
    __device__ __forceinline__ bool next(int i, Unit& u) const { if (!pg8::StaticOrder::next(i, u)) return false; u.pn += (u.pn >= 5) ? 1 : 0; return true; }
};
struct MergeOrder {
    pg8::StaticOrder S;
    __device__ __forceinline__ bool next(int i, Unit& u) const { const int ti = i / 3, br = i - ti * 3; if (!S.next(ti, u)) return false; u.pm += br * (T / 256); u.pn += br * 4; u.pn2 = 0; u.aux = 0; return true; }
    __device__ __forceinline__ int arow(const Unit&, int) const { return 0; }
    __device__ __forceinline__ void a_ready(const Unit&) const {}
    __device__ __forceinline__ void done(const Unit&) const {}
};

struct Frame {
    LAS unsigned char* lds;
    volatile LAS unsigned* MISC;
    gu32* ctl;
    int tid, lane, wave, vcu, G, bx;
};

__device__ __forceinline__ void tr_block(const float* s, int lds_, bf16* d, int ldd, LAS float* scr, int lane) {
    f32x4 v[16];
#pragma unroll
    for (int i = 0; i < 16; ++i) v[i] = *(const f32x4*)(s + (size_t)(4 * i + (lane >> 4)) * lds_ + (lane & 15) * 4);
#pragma unroll
    for (int i = 0; i < 16; ++i) { LAS float* p = scr + (4 * i + (lane >> 4)) * 65 + (lane & 15) * 4; p[0] = v[i].x; p[1] = v[i].y; p[2] = v[i].z; p[3] = v[i].w; }
    LDS_WAIT(); asm volatile("" ::: "memory");
    const int c = lane & 7;
#pragma unroll
    for (int j = 0; j < 8; ++j) { const int n = (lane >> 3) + 8 * j; const LAS float* p = scr + (8 * c) * 65 + n;
        u32x4 o; o.x = cvt_pk_bf16(p[0 * 65], p[1 * 65]); o.y = cvt_pk_bf16(p[2 * 65], p[3 * 65]); o.z = cvt_pk_bf16(p[4 * 65], p[5 * 65]); o.w = cvt_pk_bf16(p[6 * 65], p[7 * 65]);
        *(u32x4*)(d + (size_t)n * ldd + 8 * c) = o; }
    LDS_WAIT(); asm volatile("" ::: "memory");
}
__device__ __forceinline__ void convert_strip8(const Frame& F0, const float* src, int sld, signed char* dst, float* csd) {
    Frame F = F0; F.wave = opqs(F0.wave); F.lane = cur_lane();
    LAS int* scr = (LAS int*)(F.lds + F.wave * 16896);
    LAS float* cmax = (LAS float*)(F.lds + 136192);
    const int c4 = (F.lane & 15) * 4, rg = F.lane >> 4;
    f32x4 v[2][16];
#pragma unroll
    for (int b = 0; b < 2; ++b)
#pragma unroll
        for (int i = 0; i < 16; ++i) v[b][i] = *(const f32x4*)(src + (size_t)(64 * (2 * F.wave + b) + 4 * i + rg) * sld + c4);
    f32x4 mx = (f32x4){0.f, 0.f, 0.f, 0.f};
#pragma unroll
    for (int b = 0; b < 2; ++b)
#pragma unroll
        for (int i = 0; i < 16; ++i) { mx.x = fmaxf(mx.x, fabsf(v[b][i].x)); mx.y = fmaxf(mx.y, fabsf(v[b][i].y)); mx.z = fmaxf(mx.z, fabsf(v[b][i].z)); mx.w = fmaxf(mx.w, fabsf(v[b][i].w)); }
#pragma unroll
    for (int o = 16; o < 64; o <<= 1) { mx.x = fmaxf(mx.x, shfl_xor_l(mx.x, o, F.lane)); mx.y = fmaxf(mx.y, shfl_xor_l(mx.y, o, F.lane)); mx.z = fmaxf(mx.z, shfl_xor_l(mx.z, o, F.lane)); mx.w = fmaxf(mx.w, shfl_xor_l(mx.w, o, F.lane)); }
    if (F.lane < 16) *(LAS f32x4*)(cmax + F.wave * 64 + c4) = mx;
    __syncthreads();
    f32x4 am = *(const LAS f32x4*)(cmax + c4);
#pragma unroll
    for (int w = 1; w < 8; ++w) { const f32x4 o = *(const LAS f32x4*)(cmax + w * 64 + c4); am.x = fmaxf(am.x, o.x); am.y = fmaxf(am.y, o.y); am.z = fmaxf(am.z, o.z); am.w = fmaxf(am.w, o.w); }
    am.x = fmaxf(am.x, 1e-30f); am.y = fmaxf(am.y, 1e-30f); am.z = fmaxf(am.z, 1e-30f); am.w = fmaxf(am.w, 1e-30f);
    const f32x4 inv = (f32x4){127.f / am.x, 127.f / am.y, 127.f / am.z, 127.f / am.w};
    if (F.wave == 0 && F.lane < 16) *(f32x4*)(csd + c4) = am * (1.f / 127.f);
#pragma unroll
    for (int b = 0; b < 2; ++b) {
#pragma unroll
        for (int i = 0; i < 16; ++i) { LAS int* p = scr + (4 * i + rg) * 65 + c4; p[0] = q8(v[b][i].x * inv.x); p[1] = q8(v[b][i].y * inv.y); p[2] = q8(v[b][i].z * inv.z); p[3] = q8(v[b][i].w * inv.w); }
        LDS_WAIT(); asm volatile("" ::: "memory");
        const int c8 = F.lane & 7;
#pragma unroll
        for (int j = 0; j < 8; ++j) { const int n = (F.lane >> 3) + 8 * j; const LAS int* p = scr + (8 * c8) * 65 + n;
            u32x2 o; o.x = pack4_i8(p[0 * 65], p[1 * 65], p[2 * 65], p[3 * 65]); o.y = pack4_i8(p[4 * 65], p[5 * 65], p[6 * 65], p[7 * 65]);
            *(u32x2*)(dst + (size_t)n * DM + 64 * (2 * F.wave + b) + 8 * c8) = o; }
        LDS_WAIT(); asm volatile("" ::: "memory");
    }
    __syncthreads();
}
__device__ __forceinline__ void convert_strip_item(const Frame& F, unsigned char* ws, int l, const float* w_in, const float* w_gate, const float* w_up, int s) {
    if (s < 80) convert_strip8(F, w_in + (size_t)l * DM * INC + 64 * s, INC, (signed char*)(ws + WS_WG8) + (size_t)64 * s * DM, (float*)(ws + WS_CS) + 64 * s);
    else { const int t = s - 80, e = t >> 2, up = (t >> 1) & 1, nb = t & 1;
        convert_strip8(F, (up ? w_up : w_gate) + ((size_t)l * 16 + e) * DM * 128 + 64 * nb, 128, (signed char*)(ws + WS_WU8) + (size_t)(e * 256 + up * 128 + 64 * nb) * DM, (float*)(ws + WS_CSU) + e * 256 + up * 128 + 64 * nb); }
}
__device__ __forceinline__ void convert_weights(const Frame& F0, unsigned char* ws, int l, const float* w_in, const float* w_br, const float* w_o, const float* w_gate, const float* w_up, const float* w_down, const float* sg_w, int part, int widx, int wcnt) {
    Frame F = F0; F.wave = opqs(F0.wave); F.vcu = opqs(F0.vcu); F.G = opqs(F0.G); F.lane = cur_lane(); F.tid = F.wave * 64 + F.lane;
    LAS float* scr = (LAS float*)(F.lds + F.wave * 16896);
    if (widx < 0) return;
    bf16* WIN = (bf16*)(ws + WS_WIN); bf16* WBR = (bf16*)(ws + WS_WBR); bf16* WO = (bf16*)(ws + WS_WO); bf16* WGU = (bf16*)(ws + WS_WGU); bf16* WD = (bf16*)(ws + WS_WD); bf16* SGW = (bf16*)(ws + WS_SGW);
    const float* win = w_in + (size_t)l * DM * INC; const float* wbr = w_br + (size_t)l * 3 * 256 * DM; const float* wo = w_o + (size_t)l * DM * DM;
    const float* wg = w_gate + (size_t)l * 16 * DM * 128; const float* wu = w_up + (size_t)l * 16 * DM * 128; const float* wd = w_down + (size_t)l * 16 * 128 * DM;
    constexpr int I_IN = 0, I_BR = 3 * 4 * 16, I_O = 16 * 16, I_G = 0, I_U = 0, I_D = 16 * 32;
    constexpr int NIT = I_IN + I_BR + I_O + I_G + I_U + I_D, NA = I_IN + I_BR + I_O;
    const int it0 = part == 2 ? NA : 0, it1 = part == 1 ? NA : NIT;
    for (int it = it0 + widx; it < it1; it += wcnt) {
        int r = it;
        if (r < I_IN) { const int kb = r / 32, nb = r % 32; tr_block(win + (size_t)(64 * kb) * INC + 64 * nb, INC, WIN + (size_t)(64 * nb) * DM + 64 * kb, DM, scr, F.lane); continue; } r -= I_IN;
        if (r < I_BR) { const int br = r / 64, q = r % 64, kb = q / 16, nb = q % 16; tr_block(wbr + (size_t)br * 256 * DM + (size_t)(64 * kb) * DM + 64 * nb, DM, WBR + (size_t)br * DM * 256 + (size_t)(64 * nb) * 256 + 64 * kb, 256, scr, F.lane); continue; } r -= I_BR;
        if (r < I_O) { const int kb = r / 16, nb = r % 16; tr_block(wo + (size_t)(64 * kb) * DM + 64 * nb, DM, WO + (size_t)(64 * nb) * DM + 64 * kb, DM, scr, F.lane); continue; } r -= I_O;
        if (r < I_G + I_U) { const bool up = r >= I_G; if (up) r -= I_G; const int e = r / 32, q = r % 32, kb = q / 2, nb = q % 2; const float* src = (up ? wu : wg) + (size_t)e * DM * 128;
            tr_block(src + (size_t)(64 * kb) * 128 + 64 * nb, 128, WGU + (size_t)(e >> 2) * DM * DM + (size_t)((e & 3) * 256 + (up ? 128 : 0) + 64 * nb) * DM + 64 * kb, DM, scr, F.lane); continue; } r -= I_G + I_U;
        { const int e = r / 32, q = r % 32, kb = q / 16, nb = q % 16;
          tr_block(wd + (size_t)e * 128 * DM + (size_t)(64 * kb) * DM + 64 * nb, DM, WD + (size_t)e * DM * 128 + (size_t)(64 * nb) * 128 + 64 * kb, 128, scr, F.lane); }
    }
    const float* sg = sg_w + (size_t)l * 4 * 128 * 128;
    if (part != 2) for (int i = widx * 64 + F.lane; i < 4 * 128 * 128 / 2; i += wcnt * 64) { const int e = 2 * i, t = (e >> 7) & 127, s = e & 127; const f32x2 v = *(const f32x2*)(sg + e);
        ((unsigned*)SGW)[i] = cvt_pk_bf16(s <= t ? v.x : 0.f, (s + 1) <= t ? v.y : 0.f); }
}

__device__ __forceinline__ void ln_row(const float* src, const f32x4 (&gm)[4], const f32x4 (&bt)[4], int lane, f32x4 (&y)[4]) {
    const f32x4* xr = (const f32x4*)src + lane; float s = 0.f;
#pragma unroll
    for (int j = 0; j < 4; ++j) { y[j] = xr[64 * j]; s += (y[j].x + y[j].y) + (y[j].z + y[j].w); }
    const float mean = wave_sum(s, lane) * (1.f / DM); float s2 = 0.f;
#pragma unroll
    for (int j = 0; j < 4; ++j) { y[j] = y[j] - mean; s2 += (y[j].x * y[j].x + y[j].y * y[j].y) + (y[j].z * y[j].z + y[j].w * y[j].w); }
    const float rstd = 1.f / sqrtf(wave_sum(s2, lane) * (1.f / DM) + LN_EPS);
#pragma unroll
    for (int j = 0; j < 4; ++j) y[j] = y[j] * rstd * gm[j] + bt[j];
}
__device__ __forceinline__ void store_row_q8(const f32x4 (&y)[4], unsigned char* o8, float* rsp, int lane) {
    float am = 0.f;
#pragma unroll
    for (int j = 0; j < 4; ++j) am = fmaxf(fmaxf(am, fmaxf(fabsf(y[j].x), fabsf(y[j].y))), fmaxf(fabsf(y[j].z), fabsf(y[j].w)));
    am = fmaxf(wave_max(am), 1e-20f); const float inv = 127.f / am;
#pragma unroll
    for (int j = 0; j < 4; ++j) *(unsigned*)(o8 + 256 * j + 4 * lane) = pack4_i8(q8(y[j].x * inv), q8(y[j].y * inv), q8(y[j].z * inv), q8(y[j].w * inv));
    if (lane == 0) *rsp = am * (1.f / 127.f);
}
template <bool WF32, bool WBF>
__device__ __forceinline__ void store_row(const f32x4 (&y)[4], float* of, bf16* ob, int lane) {
    f32x4* o4 = (f32x4*)of + lane; u32x2* o8 = (u32x2*)ob + lane;
#pragma unroll
    for (int j = 0; j < 4; ++j) { if (WF32) o4[64 * j] = y[j]; if (WBF) { u32x2 w; w.x = cvt_pk_bf16(y[j].x, y[j].y); w.y = cvt_pk_bf16(y[j].z, y[j].w); o8[64 * j] = w; } }
}
template <int NR>
__device__ __forceinline__ void ln_rows(const float* src, const f32x4 (&gm)[4], const f32x4 (&bt)[4], int lane, f32x4 (&y)[NR][4]) {
#pragma unroll
    for (int r = 0; r < NR; ++r) { const f32x4* xr = (const f32x4*)(src + (size_t)r * DM) + lane;
#pragma unroll
        for (int j = 0; j < 4; ++j) y[r][j] = xr[64 * j]; }
#pragma unroll
    for (int r = 0; r < NR; ++r) { float s = 0.f;
#pragma unroll
        for (int j = 0; j < 4; ++j) s += (y[r][j].x + y[r][j].y) + (y[r][j].z + y[r][j].w);
        const float mean = wave_sum(s, lane) * (1.f / DM); float s2 = 0.f;
#pragma unroll
        for (int j = 0; j < 4; ++j) { y[r][j] = y[r][j] - mean; s2 += (y[r][j].x * y[r][j].x + y[r][j].y * y[r][j].y) + (y[r][j].z * y[r][j].z + y[r][j].w * y[r][j].w); }
        const float rstd = 1.f / sqrtf(wave_sum(s2, lane) * (1.f / DM) + LN_EPS);
#pragma unroll
        for (int j = 0; j < 4; ++j) y[r][j] = y[r][j] * rstd * gm[j] + bt[j]; }
}
template <bool WF32, bool WBF>
__device__ __forceinline__ void ln_phase(const Frame& F0, const float* src, const float* gam, const float* bet, float* of, bf16* ob, unsigned char* o8, float* rs) {
    Frame F = F0; F.wave = opqs(F0.wave); F.vcu = opqs(F0.vcu); F.G = opqs(F0.G); F.lane = cur_lane(); F.tid = F.wave * 64 + F.lane;
    f32x4 gm[4], bt[4];
#pragma unroll
    for (int j = 0; j < 4; ++j) { gm[j] = ((const f32x4*)gam)[F.lane + 64 * j]; bt[j] = ((const f32x4*)bet)[F.lane + 64 * j]; }
    const int gw = F.vcu * NWAVES + F.wave, NGW = F.G * NWAVES;
    for (int m = gw * 4; m < T; m += NGW * 4) { f32x4 y[4][4]; ln_rows<4>(src + (size_t)m * DM, gm, bt, F.lane, y);
#pragma unroll
        for (int r = 0; r < 4; ++r) { store_row<WF32, WBF>(y[r], of + (size_t)(m + r) * DM, ob + (size_t)(m + r) * DM, F.lane); store_row_q8(y[r], o8 + (size_t)(m + r) * DM, rs + m + r, F.lane); } }
}

#define LNB_IDX(j, hh, lane) (512 * (j) + 8 * (lane) + 4 * (hh))
__device__ __forceinline__ void load_gb_bf(const float* gam, const float* bet, int lane, f32x4 (&gm)[4], f32x4 (&bt)[4]) {
#pragma unroll
    for (int j = 0; j < 2; ++j)
#pragma unroll
        for (int hh = 0; hh < 2; ++hh) { gm[2 * j + hh] = *(const f32x4*)(gam + LNB_IDX(j, hh, lane)); bt[2 * j + hh] = *(const f32x4*)(bet + LNB_IDX(j, hh, lane)); }
}
template <int NR>
__device__ __forceinline__ void ln_rows_bf(const bf16* src, const f32x4 (&gm)[4], const f32x4 (&bt)[4], int lane, f32x4 (&y)[NR][4]) {
    u32x4 raw[NR][2];
#pragma unroll
    for (int r = 0; r < NR; ++r)
#pragma unroll
        for (int j = 0; j < 2; ++j) raw[r][j] = *(const u32x4*)(src + (size_t)r * DM + 512 * j + 8 * lane);
#pragma unroll
    for (int r = 0; r < NR; ++r) { float s = 0.f;
#pragma unroll
        for (int j = 0; j < 2; ++j) { const u32x4 w = raw[r][j]; y[r][2 * j] = (f32x4){bf_lo(w.x), bf_hi(w.x), bf_lo(w.y), bf_hi(w.y)}; y[r][2 * j + 1] = (f32x4){bf_lo(w.z), bf_hi(w.z), bf_lo(w.w), bf_hi(w.w)}; }
#pragma unroll
        for (int j = 0; j < 4; ++j) s += (y[r][j].x + y[r][j].y) + (y[r][j].z + y[r][j].w);
        const float mean = wave_sum(s, lane) * (1.f / DM); float s2 = 0.f;
#pragma unroll
        for (int j = 0; j < 4; ++j) { y[r][j] = y[r][j] - mean; s2 += (y[r][j].x * y[r][j].x + y[r][j].y * y[r][j].y) + (y[r][j].z * y[r][j].z + y[r][j].w * y[r][j].w); }
        const float rstd = 1.f / sqrtf(wave_sum(s2, lane) * (1.f / DM) + LN_EPS);
#pragma unroll
        for (int j = 0; j < 4; ++j) y[r][j] = y[r][j] * rstd * gm[j] + bt[j]; }
}
__device__ __forceinline__ void store_row_bf_q8(const f32x4 (&y)[4], unsigned char* o8, float* rsp, int lane, LAS float* rsl = nullptr) {
    float am = 0.f;
#pragma unroll
    for (int j = 0; j < 4; ++j) am = fmaxf(fmaxf(am, fmaxf(fabsf(y[j].x), fabsf(y[j].y))), fmaxf(fabsf(y[j].z), fabsf(y[j].w)));
    am = fmaxf(wave_max(am), 1e-20f); const float inv = 127.f / am;
#pragma unroll
    for (int j = 0; j < 2; ++j) { u32x2 w; w.x = pack4_i8(q8(y[2 * j].x * inv), q8(y[2 * j].y * inv), q8(y[2 * j].z * inv), q8(y[2 * j].w * inv)); w.y = pack4_i8(q8(y[2 * j + 1].x * inv), q8(y[2 * j + 1].y * inv), q8(y[2 * j + 1].z * inv), q8(y[2 * j + 1].w * inv));
        *(u32x2*)(o8 + 512 * j + 8 * lane) = w; }
    if (lane == 0) { if (rsl) *rsl = am * (1.f / 127.f); else *rsp = am * (1.f / 127.f); }
}
template <bool WF32, bool WBF>
__device__ __forceinline__ void store_row_bf(const f32x4 (&y)[4], float* of, bf16* ob, int lane) {
#pragma unroll
    for (int j = 0; j < 2; ++j) {
        if (WF32) { *(f32x4*)(of + 512 * j + 8 * lane) = y[2 * j]; *(f32x4*)(of + 512 * j + 8 * lane + 4) = y[2 * j + 1]; }
        if (WBF) { u32x4 w; w.x = cvt_pk_bf16(y[2 * j].x, y[2 * j].y); w.y = cvt_pk_bf16(y[2 * j].z, y[2 * j].w); w.z = cvt_pk_bf16(y[2 * j + 1].x, y[2 * j + 1].y); w.w = cvt_pk_bf16(y[2 * j + 1].z, y[2 * j + 1].w);
            *(u32x4*)(ob + 512 * j + 8 * lane) = w; } }
}
template <bool WF32, bool WBF>
__device__ __forceinline__ void ln_phase_bf(const Frame& F0, const bf16* src, const float* gam, const float* bet, float* of, bf16* ob, unsigned char* o8, float* rs) {
    Frame F = F0; F.wave = opqs(F0.wave); F.vcu = opqs(F0.vcu); F.G = opqs(F0.G); F.lane = cur_lane(); F.tid = F.wave * 64 + F.lane;
    f32x4 gm[4], bt[4]; load_gb_bf(gam, bet, F.lane, gm, bt);
    const int gw = F.vcu * NWAVES + F.wave, NGW = F.G * NWAVES;
    for (int m = gw * 8; m < T; m += NGW * 8) { f32x4 y[8][4]; ln_rows_bf<8>(src + (size_t)m * DM, gm, bt, F.lane, y);
#pragma unroll
        for (int r = 0; r < 8; ++r) { store_row_bf<WF32, WBF>(y[r], of + (size_t)(m + r) * DM, ob + (size_t)(m + r) * DM, F.lane); if (WBF) store_row_bf_q8(y[r], o8 + (size_t)(m + r) * DM, rs + m + r, F.lane); } }
}

__device__ __forceinline__ void ln_router_phase(const Frame& F0, const bf16* src, bf16* hb, unsigned char* hb8, const float* gam, const float* bet, const float* w_router, const float* rbias, int* perm, float* dwp, gu32* gcnt) {
    Frame F = F0; F.wave = opqs(F0.wave); F.vcu = opqs(F0.vcu); F.G = opqs(F0.G); F.lane = cur_lane(); F.tid = F.wave * 64 + F.lane;
    constexpr int ATS = 1028;
    LAS float* AT = (LAS float*)F.lds;
    LAS float* PART = (LAS float*)(F.lds + 65792);
    LAS float* LOG = (LAS float*)(F.lds + 73984);
    LAS int* lcnt = (LAS int*)(F.lds + 90368);
    LAS int* lbase = (LAS int*)(F.lds + 90368 + 128);
    LAS int* rinfo = (LAS int*)(F.lds + 90368 + 256);
    LAS f32x4* dwl = (LAS f32x4*)(F.lds + 90368 + 2048);
    LAS float* rsl = (LAS float*)(F.lds + 90368 + 8192);
    const int RPB = T / F.G, NT = RPB / 16, row0 = F.vcu * RPB;
    if (F.tid < NBK) lcnt[F.tid] = 0;
    f32x4 gm[4], bt[4]; load_gb_bf(gam, bet, F.lane, gm, bt);
    const int mr = F.lane & 15, kq = F.lane >> 4;
    float wreg[32];
#pragma unroll
    for (int s = 0; s < 32; ++s) wreg[s] = w_router[(size_t)(128 * F.wave + 32 * kq + s) * 16 + mr];
    u32x4 raw[2][2];
#pragma unroll
    for (int r = 0; r < 2; ++r)
#pragma unroll
        for (int j = 0; j < 2; ++j) raw[r][j] = *(const u32x4*)(src + (size_t)(row0 + F.wave * 2 + r) * DM + 512 * j + 8 * F.lane);
    for (int t = 0; t < NT; ++t) {
        f32x4 y[2][4];
#pragma unroll
        for (int r = 0; r < 2; ++r) { float sm = 0.f;
#pragma unroll
            for (int j = 0; j < 2; ++j) { const u32x4 w = raw[r][j]; y[r][2 * j] = (f32x4){bf_lo(w.x), bf_hi(w.x), bf_lo(w.y), bf_hi(w.y)}; y[r][2 * j + 1] = (f32x4){bf_lo(w.z), bf_hi(w.z), bf_lo(w.w), bf_hi(w.w)}; }
#pragma unroll
            for (int j = 0; j < 4; ++j) sm += (y[r][j].x + y[r][j].y) + (y[r][j].z + y[r][j].w);
            const float mean = wave_sum(sm, F.lane) * (1.f / DM); float s2 = 0.f;
#pragma unroll
            for (int j = 0; j < 4; ++j) { y[r][j] = y[r][j] - mean; s2 += (y[r][j].x * y[r][j].x + y[r][j].y * y[r][j].y) + (y[r][j].z * y[r][j].z + y[r][j].w * y[r][j].w); }
            const float rstd = 1.f / sqrtf(wave_sum(s2, F.lane) * (1.f / DM) + LN_EPS);
#pragma unroll
            for (int j = 0; j < 4; ++j) y[r][j] = y[r][j] * rstd * gm[j] + bt[j]; }
        if (t + 1 < NT) {
#pragma unroll
            for (int r = 0; r < 2; ++r)
#pragma unroll
                for (int j = 0; j < 2; ++j) raw[r][j] = *(const u32x4*)(src + (size_t)(row0 + (t + 1) * 16 + F.wave * 2 + r) * DM + 512 * j + 8 * F.lane);
        }
#pragma unroll
        for (int r = 0; r < 2; ++r) { const int lr = F.wave * 2 + r; store_row_bf<false, true>(y[r], (float*)nullptr, hb + (size_t)(row0 + t * 16 + lr) * DM, F.lane);
            store_row_bf_q8(y[r], hb8 + (size_t)(row0 + t * 16 + lr) * DM, (float*)nullptr, F.lane, rsl + t * 16 + lr);
#pragma unroll
            for (int j = 0; j < 2; ++j) { *(LAS f32x4*)(AT + lr * ATS + 512 * j + 8 * F.lane) = y[r][2 * j]; *(LAS f32x4*)(AT + lr * ATS + 512 * j + 8 * F.lane + 4) = y[r][2 * j + 1]; } }
        __syncthreads();
        f32x4 acc = (f32x4){0.f, 0.f, 0.f, 0.f};
        { const LAS float* ap = AT + mr * ATS + 128 * F.wave + 32 * kq; f32x4 av[8];
#pragma unroll
          for (int q = 0; q < 8; ++q) av[q] = *(const LAS f32x4*)(ap + 4 * q);
#pragma unroll
          for (int q = 0; q < 8; ++q) { acc = __builtin_amdgcn_mfma_f32_16x16x4f32(av[q].x, wreg[4 * q], acc, 0, 0, 0); acc = __builtin_amdgcn_mfma_f32_16x16x4f32(av[q].y, wreg[4 * q + 1], acc, 0, 0, 0);
              acc = __builtin_amdgcn_mfma_f32_16x16x4f32(av[q].z, wreg[4 * q + 2], acc, 0, 0, 0); acc = __builtin_amdgcn_mfma_f32_16x16x4f32(av[q].w, wreg[4 * q + 3], acc, 0, 0, 0); } }
#pragma unroll
        for (int i = 0; i < 4; ++i) PART[(F.wave * 16 + 4 * kq + i) * 16 + mr] = acc[i];
        __syncthreads();
        if (F.tid < 256) { float sacc = 0.f;
#pragma unroll
            for (int w8 = 0; w8 < 8; ++w8) sacc += PART[w8 * 256 + F.tid];
            LOG[(t * 16 + (F.tid >> 4)) * 16 + (F.tid & 15)] = sacc; }
    }
    __syncthreads();
    float rb[16];
#pragma unroll
    for (int e = 0; e < 16; ++e) rb[e] = rbias[e];
    if (F.tid < RPB) {
        const int m = row0 + F.tid;
        float sc[16], sel[16];
#pragma unroll
        for (int q = 0; q < 4; ++q) { const f32x4 lg = *(const LAS f32x4*)(LOG + F.tid * 16 + 4 * q);
            sc[4 * q] = 1.f / (1.f + __expf(-lg.x)); sc[4 * q + 1] = 1.f / (1.f + __expf(-lg.y)); sc[4 * q + 2] = 1.f / (1.f + __expf(-lg.z)); sc[4 * q + 3] = 1.f / (1.f + __expf(-lg.w)); }
#pragma unroll
        for (int e = 0; e < 16; ++e) sel[e] = sc[e] + rb[e];
        float gs[4];
#pragma unroll
        for (int g = 0; g < 4; ++g) { const float a = sel[4 * g], b = sel[4 * g + 1], c = sel[4 * g + 2], d = sel[4 * g + 3];
            const float h1 = fmaxf(a, b), l1 = fminf(a, b), h2 = fmaxf(c, d), l2 = fminf(c, d); gs[g] = fmaxf(h1, h2) + fmaxf(fminf(h1, h2), fmaxf(l1, l2)); }
        int bg = 0; float bs = gs[0];
#pragma unroll
        for (int g = 1; g < 4; ++g) if (gs[g] > bs) { bs = gs[g]; bg = g; }
        float v[4], s4[4];
#pragma unroll
        for (int j = 0; j < 4; ++j) { v[j] = bg == 0 ? sel[j] : bg == 1 ? sel[4 + j] : bg == 2 ? sel[8 + j] : sel[12 + j]; s4[j] = bg == 0 ? sc[j] : bg == 1 ? sc[4 + j] : bg == 2 ? sc[8 + j] : sc[12 + j]; }
        int i1 = 0; float m1 = v[0];
#pragma unroll
        for (int j = 1; j < 4; ++j) if (v[j] > m1) { m1 = v[j]; i1 = j; }
        int i2 = -1; float m2 = -3.0e38f;
#pragma unroll
        for (int j = 0; j < 4; ++j) if (j != i1 && v[j] > m2) { m2 = v[j]; i2 = j; }
        const float s1 = i1 == 0 ? s4[0] : i1 == 1 ? s4[1] : i1 == 2 ? s4[2] : s4[3], s2 = i2 == 0 ? s4[0] : i2 == 1 ? s4[1] : i2 == 2 ? s4[2] : s4[3];
        const float inv = 1.f / (s1 + s2), w1 = s1 * inv, w2 = s2 * inv;
        const int lo = i1 < i2 ? i1 : i2, hi = i1 < i2 ? i2 : i1, bk = bg * 6 + (lo == 0 ? hi - 1 : lo == 1 ? hi + 1 : 5);
        const f32x2 dw = (f32x2){i1 < i2 ? w1 : w2, i1 < i2 ? w2 : w1};
        const int rank = atomicAdd((int*)&lcnt[bk], 1); rinfo[F.tid] = m | (bk << 16) | (rank << 21); dwl[F.tid] = (f32x4){dw.x, dw.y, rsl[F.tid], 0.f};
    }
    __syncthreads();
    if (F.tid < NBK) lbase[F.tid] = (int)__hip_atomic_fetch_add(gcnt + F.tid, (unsigned)lcnt[F.tid], RLX_AGENT);
    __syncthreads();
    if (F.tid < RPB) { const int info = rinfo[F.tid]; const int tok = info & 0xffff, bk = (info >> 16) & 31, rank = info >> 21; const size_t slot = (size_t)bk * T + lbase[bk] + rank;
        perm[slot] = tok; ((f32x4*)dwp)[slot] = dwl[F.tid]; }
    __syncthreads();
}

__device__ __forceinline__ void conv_phase(const Frame& F0, const bf16* PA, const float* cw, bf16* Y0) {
    Frame F = F0; F.wave = opqs(F0.wave); F.vcu = opqs(F0.vcu); F.G = opqs(F0.G); F.lane = cur_lane(); F.tid = F.wave * 64 + F.lane;
    for (int rr = F.vcu * NTHREADS + F.tid; rr < (T / 8) * 32; rr += F.G * NTHREADS) {
        const int co = rr & 31, run = rr >> 5, t0 = run * 8, c0 = co * 8;
        float w[3][8];
#pragma unroll
        for (int j = 0; j < 3; ++j) { const f32x4 a = *(const f32x4*)(cw + j * 256 + c0), b = *(const f32x4*)(cw + j * 256 + c0 + 4); w[j][0] = a.x; w[j][1] = a.y; w[j][2] = a.z; w[j][3] = a.w; w[j][4] = b.x; w[j][5] = b.y; w[j][6] = b.z; w[j][7] = b.w; }
        float u1[8], u2[8];
        const bool first = (t0 % SEQ) == 0;
#pragma unroll
        for (int q = 0; q < 8; ++q) { u1[q] = 0.f; u2[q] = 0.f; }
        if (!first) {
            const u32x4 h1 = *(const u32x4*)(PA + (size_t)(t0 - 1) * 768 + c0), g1 = *(const u32x4*)(PA + (size_t)(t0 - 1) * 768 + 512 + c0);
            const u32x4 h2 = *(const u32x4*)(PA + (size_t)(t0 - 2) * 768 + c0), g2 = *(const u32x4*)(PA + (size_t)(t0 - 2) * 768 + 512 + c0);
#pragma unroll
            for (int q = 0; q < 4; ++q) { u1[2 * q] = bf_lo(h1[q]) * bf_lo(g1[q]); u1[2 * q + 1] = bf_hi(h1[q]) * bf_hi(g1[q]); u2[2 * q] = bf_lo(h2[q]) * bf_lo(g2[q]); u2[2 * q + 1] = bf_hi(h2[q]) * bf_hi(g2[q]); }
        }
#pragma unroll
        for (int i = 0; i < 8; ++i) { const bf16* row = PA + (size_t)(t0 + i) * 768 + c0;
            const u32x4 hh = *(const u32x4*)row, bb = *(const u32x4*)(row + 256), cc = *(const u32x4*)(row + 512);
            float u0[8], yv[8];
#pragma unroll
            for (int q = 0; q < 4; ++q) { u0[2 * q] = bf_lo(hh[q]) * bf_lo(cc[q]); u0[2 * q + 1] = bf_hi(hh[q]) * bf_hi(cc[q]); }
#pragma unroll
            for (int q = 0; q < 8; ++q) { const float bgv = (q & 1) ? bf_hi(bb[q >> 1]) : bf_lo(bb[q >> 1]); yv[q] = bgv * (w[0][q] * u2[q] + w[1][q] * u1[q] + w[2][q] * u0[q]); u2[q] = u1[q]; u1[q] = u0[q]; }
            u32x4 o; o.x = cvt_pk_bf16(yv[0], yv[1]); o.y = cvt_pk_bf16(yv[2], yv[3]); o.z = cvt_pk_bf16(yv[4], yv[5]); o.w = cvt_pk_bf16(yv[6], yv[7]);
            *(u32x4*)(Y0 + (size_t)(t0 + i) * 256 + c0) = o; }
    }
}

__device__ __forceinline__ void attn_unit(const bf16* Q, const bf16* Kb, const bf16* VT, bf16* Y1, int b, int hd, int qt, int lane) {
    const int r = lane & 31, h = lane >> 5;
    const size_t tokb = (size_t)b * SEQ;
    bf16x8 qf[4];
    { const bf16* qp = Q + (tokb + qt * 32 + r) * 256 + hd * 64 + 8 * h;
#pragma unroll
      for (int s = 0; s < 4; ++s) qf[s] = *(const bf16x8*)(qp + 16 * s); }
    f32x16 o0, o1;
#pragma unroll
    for (int i = 0; i < 16; ++i) { o0[i] = 0.f; o1[i] = 0.f; }
    float R = 1.f;
    bf16x8 kf[4], vf[2][2], kn[4], vn[2][2];
#define AT_LOAD(KF, VF, kt_) do { const bf16* kp = Kb + (tokb + (kt_) * 32 + r) * 256 + hd * 64 + 8 * h; \
        _Pragma("unroll") for (int s = 0; s < 4; ++s) KF[s] = *(const bf16x8*)(kp + 16 * s); \
        _Pragma("unroll") for (int db = 0; db < 2; ++db) _Pragma("unroll") for (int s = 0; s < 2; ++s) { const bf16* vp = VT + (((size_t)hd * (T / 32) + (size_t)b * (SEQ / 32) + (kt_)) * 64 + db * 32 + r) * 32 + 16 * s + 4 * h; \
            const u32x2 lo = *(const u32x2*)vp, hi = *(const u32x2*)(vp + 8); const u32x4 w = (u32x4){lo.x, lo.y, hi.x, hi.y}; VF[db][s] = __builtin_bit_cast(bf16x8, w); } } while (0)
    AT_LOAD(kf, vf, qt);
    for (int kt = qt; kt >= 0; --kt) {
        { const int ktn = kt > 0 ? kt - 1 : 0; AT_LOAD(kn, vn, ktn); }
        f32x16 st;
#pragma unroll
        for (int i = 0; i < 16; ++i) st[i] = 0.f;
#pragma unroll
        for (int s = 0; s < 4; ++s) st = __builtin_amdgcn_mfma_f32_32x32x16_bf16(kf[s], qf[s], st, 0, 0, 0);
        float nb[16], bt_[16];
        const bool diag = (kt == qt);
#pragma unroll
        for (int i = 0; i < 16; ++i) { const float z = st[i]; const float e2 = __builtin_amdgcn_exp2f(-fabsf(z)); const float rr = __builtin_amdgcn_rcpf(1.f + e2), er = e2 * rr;
            const int kidx = (i & 3) + 8 * (i >> 2) + 4 * h; const bool valid = !diag || (kidx < r);
            const float b1 = z >= 0.f ? rr : er, n1 = z >= 0.f ? er : rr;
            nb[i] = valid ? n1 : 1.f; bt_[i] = valid ? b1 : 0.f; }
        float Gs[4], Go[4];
#pragma unroll
        for (int g = 0; g < 4; ++g) { Gs[g] = (nb[4 * g] * nb[4 * g + 1]) * (nb[4 * g + 2] * nb[4 * g + 3]); Go[g] = shfl_xor_l(Gs[g], 32, lane); }
        float tail[4]; tail[3] = 1.f; tail[2] = Gs[3] * Go[3]; tail[1] = tail[2] * (Gs[2] * Go[2]); tail[0] = tail[1] * (Gs[1] * Go[1]);
        const float total = tail[0] * (Gs[0] * Go[0]);
        float p[16];
#pragma unroll
        for (int g = 0; g < 4; ++g) { const float base = R * tail[g] * (h == 0 ? Go[g] : 1.f);
            const float w3 = base, w2 = w3 * nb[4 * g + 3], w1 = w2 * nb[4 * g + 2], w0 = w1 * nb[4 * g + 1];
            p[4 * g + 3] = bt_[4 * g + 3] * w3; p[4 * g + 2] = bt_[4 * g + 2] * w2; p[4 * g + 1] = bt_[4 * g + 1] * w1; p[4 * g] = bt_[4 * g] * w0; }
        R *= total;
        bf16x8 pf[2];
#pragma unroll
        for (int s = 0; s < 2; ++s) { u32x4 w; w.x = cvt_pk_bf16(p[8 * s], p[8 * s + 1]); w.y = cvt_pk_bf16(p[8 * s + 2], p[8 * s + 3]); w.z = cvt_pk_bf16(p[8 * s + 4], p[8 * s + 5]); w.w = cvt_pk_bf16(p[8 * s + 6], p[8 * s + 7]); pf[s] = __builtin_bit_cast(bf16x8, w); }
#pragma unroll
        for (int s = 0; s < 2; ++s) { o0 = __builtin_amdgcn_mfma_f32_32x32x16_bf16(vf[0][s], pf[s], o0, 0, 0, 0); o1 = __builtin_amdgcn_mfma_f32_32x32x16_bf16(vf[1][s], pf[s], o1, 0, 0, 0); }
        if (__all(R < 1.2664e-14f)) break;
#pragma unroll
        for (int s = 0; s < 4; ++s) kf[s] = kn[s];
#pragma unroll
        for (int db = 0; db < 2; ++db)
#pragma unroll
            for (int s = 0; s < 2; ++s) vf[db][s] = vn[db][s];
    }
#undef AT_LOAD
    bf16* yp = Y1 + (tokb + qt * 32 + r) * 256 + hd * 64 + 4 * h;
#pragma unroll
    for (int g = 0; g < 4; ++g) { u32x2 w; w.x = cvt_pk_bf16(o0[4 * g], o0[4 * g + 1]); w.y = cvt_pk_bf16(o0[4 * g + 2], o0[4 * g + 3]); *(u32x2*)(yp + 8 * g) = w;
        u32x2 w1; w1.x = cvt_pk_bf16(o1[4 * g], o1[4 * g + 1]); w1.y = cvt_pk_bf16(o1[4 * g + 2], o1[4 * g + 3]); *(u32x2*)(yp + 32 + 8 * g) = w1; }
}
__device__ __forceinline__ void attn_phase(const Frame& F0, const bf16* Q, const bf16* Kb, const bf16* VT, bf16* Y1) {
    Frame F = F0; F.wave = opqs(F0.wave); F.vcu = opqs(F0.vcu); F.G = opqs(F0.G); F.lane = cur_lane(); F.tid = F.wave * 64 + F.lane;
    const int gw = F.vcu * NWAVES + F.wave, NGW = F.G * NWAVES;
    for (int u = gw; u < (T / 32) * 4; u += NGW) { const int hd = u >> 10, tt = u & 1023, b = tt >> 9, qt = tt & 511; attn_unit(Q, Kb, VT, Y1, b, hd, qt, F.lane); }
}

constexpr int VTP = 136;
__device__ __forceinline__ void gmlp_phase(const Frame& F0, const bf16* UC, const bf16* SGW, const float* sgb, const float* lng, const float* lnb, bf16* Y2) {
    Frame F = F0; F.wave = opqs(F0.wave); F.vcu = opqs(F0.vcu); F.G = opqs(F0.G); F.lane = cur_lane(); F.tid = F.wave * 64 + F.lane;
    LAS bf16* VTl = (LAS bf16*)F.lds;
    const int lane = F.lane, w = F.wave, r = lane & 31, h = lane >> 5;
    const f32x4 g4 = ((const f32x4*)lng)[lane], b4 = ((const f32x4*)lnb)[lane];
    for (int ch = F.vcu; ch < T / 128; ch += F.G) {
        const size_t tok0 = (size_t)ch * 128;
        bf16x8 wfr[8][2];
        { const int g_ = w >> 1, th_ = w & 1;
#pragma unroll
          for (int ks = 0; ks < 8; ++ks)
#pragma unroll
              for (int tb = 0; tb < 2; ++tb) wfr[ks][tb] = *(const bf16x8*)(SGW + ((size_t)g_ * 128 + 64 * th_ + 32 * tb + r) * 128 + 16 * ks + 8 * h); }
        u32x2 raw[16];
#pragma unroll
        for (int i = 0; i < 16; ++i) raw[i] = *(const u32x2*)(UC + (tok0 + w * 16 + i) * 512 + 256 + 4 * lane);
#pragma unroll
        for (int ip = 0; ip < 8; ++ip) { unsigned pk[2][2];
#pragma unroll
            for (int q = 0; q < 2; ++q) { const u32x2 rw = raw[2 * ip + q];
                float x0 = bf_lo(rw.x), x1 = bf_hi(rw.x), x2 = bf_lo(rw.y), x3 = bf_hi(rw.y);
                const float mean = wave_sum((x0 + x1) + (x2 + x3), lane) * (1.f / 256.f); x0 -= mean; x1 -= mean; x2 -= mean; x3 -= mean;
                const float rstd = 1.f / sqrtf(wave_sum((x0 * x0 + x1 * x1) + (x2 * x2 + x3 * x3), lane) * (1.f / 256.f) + LN_EPS);
                pk[q][0] = cvt_pk_bf16(x0 * rstd * g4.x + b4.x, x1 * rstd * g4.y + b4.y); pk[q][1] = cvt_pk_bf16(x2 * rstd * g4.z + b4.z, x3 * rstd * g4.w + b4.w); }
            const int s0 = w * 16 + 2 * ip;
            LAS unsigned* vt32 = (LAS unsigned*)VTl;
            vt32[((4 * lane + 0) * VTP + s0) >> 1] = (pk[0][0] & 0xffffu) | (pk[1][0] << 16); vt32[((4 * lane + 1) * VTP + s0) >> 1] = (pk[0][0] >> 16) | (pk[1][0] & 0xffff0000u);
            vt32[((4 * lane + 2) * VTP + s0) >> 1] = (pk[0][1] & 0xffffu) | (pk[1][1] << 16); vt32[((4 * lane + 3) * VTP + s0) >> 1] = (pk[0][1] >> 16) | (pk[1][1] & 0xffff0000u); }
        __syncthreads();
        const int g = w >> 1, th = w & 1;
        f32x16 acc[2][2];
#pragma unroll
        for (int a = 0; a < 2; ++a)
#pragma unroll
            for (int b = 0; b < 2; ++b)
#pragma unroll
                for (int i = 0; i < 16; ++i) acc[a][b][i] = 0.f;
#pragma unroll
        for (int ks = 0; ks < 8; ++ks) {
            bf16x8 af[2];
#pragma unroll
            for (int cb = 0; cb < 2; ++cb) af[cb] = *(const LAS bf16x8*)(VTl + (g * 64 + cb * 32 + r) * VTP + 16 * ks + 8 * h);
#pragma unroll
            for (int cb = 0; cb < 2; ++cb)
#pragma unroll
                for (int tb = 0; tb < 2; ++tb) acc[cb][tb] = __builtin_amdgcn_mfma_f32_32x32x16_bf16(af[cb], wfr[ks][tb], acc[cb][tb], 0, 0, 0);
        }
#pragma unroll
        for (int tb = 0; tb < 2; ++tb) { const int t = 64 * th + 32 * tb + r; const float bias = sgb[g * 128 + t]; const size_t tok = tok0 + t;
#pragma unroll
            for (int cb = 0; cb < 2; ++cb)
#pragma unroll
                for (int q = 0; q < 4; ++q) { const int c0 = g * 64 + cb * 32 + 8 * q + 4 * h; const u32x2 uu = *(const u32x2*)(UC + tok * 512 + c0);
                    u32x2 o; o.x = cvt_pk_bf16(bf_lo(uu.x) * (acc[cb][tb][4 * q] + bias), bf_hi(uu.x) * (acc[cb][tb][4 * q + 1] + bias));
                    o.y = cvt_pk_bf16(bf_lo(uu.y) * (acc[cb][tb][4 * q + 2] + bias), bf_hi(uu.y) * (acc[cb][tb][4 * q + 3] + bias));
                    *(u32x2*)(Y2 + tok * 256 + c0) = o; } }
        __syncthreads();
    }
}

template <class Tp> __device__ __forceinline__ Tp* karg(int idx) {
    int off = 8 * idx; asm volatile("" : "+s"(off));
    const __attribute__((address_space(4))) char* kp = (const __attribute__((address_space(4))) char*)__builtin_amdgcn_kernarg_segment_ptr();
    const unsigned long long v = *(const __attribute__((address_space(4))) unsigned long long*)(kp + off);
    return (Tp*)(GAS Tp*)v;
}
#define KIN(i) karg<const float>(i)
#define KOUT() karg<float>(21)
#define KWS() karg<unsigned char>(22)
struct Args { const float* in[21]; float* out; unsigned char* ws; int ph_lo, ph_hi; };
__global__ void __launch_bounds__(NTHREADS, 2) fwd(Args args) {
    extern __shared__ __attribute__((aligned(16))) unsigned char lds[];
    Frame F;
    F.lds = (LAS unsigned char*)lds;
    F.MISC = (volatile LAS unsigned*)(F.lds + MISC_OFF);
    F.wave = __builtin_amdgcn_readfirstlane((int)threadIdx.x >> 6); F.lane = 0; F.tid = 0;
    F.G = gridDim.x; F.bx = blockIdx.x; { const int bx = blockIdx.x; F.vcu = (F.G % 8 == 0) ? (bx % 8) * (F.G / 8) + bx / 8 : bx; }
    F.ctl = (gu32*)(KWS() + WS_CTL);
    for (int u = threadIdx.x; u < (LDS_BYTES - LDSCTL_OFF) / 4; u += NTHREADS) ((LAS unsigned*)(F.lds + LDSCTL_OFF))[u] = 0u;
    __syncthreads();
    for (int i = threadIdx.x; i < SIGT_N; i += NTHREADS) { const float x = -8.f + ((float)i + 0.5f) * (1.f / 128.f); ((LAS unsigned char*)(F.lds + SIGT_OFF))[i] = (unsigned char)(255.f / (1.f + __expf(-x)) + 0.5f); }
    __syncthreads();
    XcdBarrier bar = xcd_barrier_post((unsigned*)(F.ctl + CW_BAR), F.MISC + 8);
    const int lo = args.ph_lo, hi = args.ph_hi;
#define IN(k) (lo <= (k) && (k) < hi)
#define SEAM(k) do { if (IN(k) && IN((k) + 1)) for (int rb_ = 0; rb_ < REP_BAR; ++rb_) { XcdBarrier b2; b2.bar = (unsigned*)((gu32*)(KWS() + WS_CTL) + CW_BAR); b2.x = (unsigned)opqs((int)bar.x); b2.st = F.MISC + 8; xcd_barrier(b2, opqs(F.wave) == 0 && cur_lane() == 0); } } while (0)

    if (IN(0)) {
        for (int rep = 0; rep < REP_P0; ++rep) {
        for (int s_ = opqs(F.vcu); s_ < 144; s_ += opqs(F.G)) convert_strip_item(F, KWS(), 0, KIN(3), KIN(16), KIN(17), s_);
        convert_weights(F, KWS(), 0, KIN(3), KIN(10), KIN(11), KIN(16), KIN(17), KIN(18), KIN(6), 0, opqs(F.vcu) * NWAVES + opqs(F.wave), opqs(F.G) * NWAVES);
        ln_phase<false, true>(F, KIN(0), KIN(1), KIN(2), KOUT(), (bf16*)(KWS() + WS_HB), KWS() + WS_HB8, (float*)(KWS() + WS_RS)); }
        SEAM(0);
    }
    for (int l = 0; l < DEPTH; ++l) {
        const int p0 = 1 + 8 * l;
        if (IN(p0)) {
            { unsigned char* ws = KWS(); pg8::Gemm g{(bf16*)(ws + WS_HB8), (bf16*)(ws + WS_WG8), T, 7 * 256, DM / 2, 0}; ProjOrder S; S.init(T, 7 * 256, opqs(F.G), opqs(F.bx));
              EpiProj E{(bf16*)(ws + WS_PA), (bf16*)(ws + WS_Q), (bf16*)(ws + WS_K), (bf16*)(ws + WS_UC), (unsigned char*)(ws + WS_GATE), KIN(4) + (size_t)l * 3 * DM, (const LAS unsigned char*)(F.lds + SIGT_OFF), (const float*)(ws + WS_RS), (const float*)(ws + WS_CS)};
              pg8::gemm_phase<EpiProj, ProjOrder, true, false, false, true>(F.lds, opqs(F.wave), g, S, E); }
            { unsigned char* ws = KWS(); pg8::Gemm g{(bf16*)(ws + WS_WG8 + (size_t)1280 * DM), (bf16*)(ws + WS_HB8), 256, T, DM / 2, 0}; pg8::StaticOrder S; { const int G_ = opqs(F.G); S.init(256, T, G_, (opqs(F.bx) + G_ / 2) % G_); }
              EpiVt E{(bf16*)(ws + WS_VT), (const float*)(ws + WS_RS), (const float*)(ws + WS_CS)};
              pg8::gemm_phase<EpiVt, pg8::StaticOrder, true, false, false, true>(F.lds, opqs(F.wave), g, S, E); }
            { unsigned char* ws = KWS(); pg8::Gemm g{(bf16*)(ws + WS_HB8), (bf16*)(ws + WS_WG8 + (size_t)2048 * DM), T, 12 * 256, DM / 2, 0}; pg8::StaticOrder S; S.init(T, 12 * 256, opqs(F.G), opqs(F.bx));
              EpiGate E{(unsigned char*)(ws + WS_GATE), KIN(4) + (size_t)l * 3 * DM, (const float*)(ws + WS_RS), (const float*)(ws + WS_CS) + 2048, (const LAS unsigned char*)(F.lds + SIGT_OFF)};
              pg8::gemm_phase<EpiGate, pg8::StaticOrder, true, false, false, true>(F.lds, opqs(F.wave), g, S, E); }
            SEAM(p0);
        }
        if (IN(p0 + 1)) {
            for (int rep = 0; rep < REP_P2; ++rep) {
            if (l > 0) { for (int s_ = 80 + opqs(F.vcu); s_ < 144; s_ += opqs(F.G)) convert_strip_item(F, KWS(), l, KIN(3), KIN(16), KIN(17), s_);
                convert_weights(F, KWS(), l, KIN(3), KIN(10), KIN(11), KIN(16), KIN(17), KIN(18), KIN(6), 2, opqs(F.vcu) * NWAVES + opqs(F.wave), opqs(F.G) * NWAVES); __syncthreads(); }
            for (int ra = 0; ra < REP_P2A; ++ra) { unsigned char* ws = KWS(); attn_phase(F, (bf16*)(ws + WS_Q), (bf16*)(ws + WS_K), (bf16*)(ws + WS_VT), (bf16*)(ws + WS_Y) + (size_t)T * 256); }
            for (int rb = 0; rb < REP_P2B; ++rb) { unsigned char* ws = KWS(); gmlp_phase(F, (bf16*)(ws + WS_UC), (bf16*)(ws + WS_SGW), KIN(7) + (size_t)l * 512, KIN(8) + (size_t)l * 256, KIN(9) + (size_t)l * 256, (bf16*)(ws + WS_Y) + (size_t)2 * T * 256); }
            for (int rc = 0; rc < REP_P2C; ++rc) { unsigned char* ws = KWS(); conv_phase(F, (bf16*)(ws + WS_PA), KIN(5) + (size_t)l * 768, (bf16*)(ws + WS_Y)); }
            }
            SEAM(p0 + 1);
        }
        if (IN(p0 + 2)) {
            for (int rep = 0; rep < REP_P3; ++rep) {
            unsigned char* ws = KWS(); pg8::Gemm g{(bf16*)(ws + WS_Y), (bf16*)(ws + WS_WBR), 3 * T, 3 * DM, 256}; MergeOrder S; S.S.init(T, DM, opqs(F.G), opqs(F.bx));
            EpiMerge E{(const unsigned char*)(ws + WS_GATE), (bf16*)(ws + WS_MG)};
            pg8::gemm_phase<EpiMerge, MergeOrder, true, false>(F.lds, opqs(F.wave), g, S, E); }
            SEAM(p0 + 2);
        }
        if (IN(p0 + 3)) {
            for (int rep = 0; rep < REP_P4; ++rep) {
            unsigned char* ws = KWS(); pg8::Gemm g{(bf16*)(ws + WS_MG), (bf16*)(ws + WS_WO), T, DM, DM}; pg8::StaticOrder S; S.init(T, DM, opqs(F.G), opqs(F.bx));
            EpiWo E{(bf16*)(ws + WS_HB), (bf16*)(ws + (rep + 1 < REP_P4 ? WS_PRE + 64 * MiB : WS_PRE))};
            pg8::gemm_phase<EpiWo, pg8::StaticOrder, true, false>(F.lds, opqs(F.wave), g, S, E); }
            SEAM(p0 + 3);
        }
        if (IN(p0 + 4)) {
            { unsigned char* ws = KWS();
            ln_router_phase(F, (bf16*)(ws + WS_PRE), (bf16*)(ws + WS_HB), ws + WS_HB8, KIN(12) + (size_t)l * DM, KIN(13) + (size_t)l * DM, KIN(14), KIN(15), (int*)(ws + WS_PERM), (float*)(ws + WS_DWP), (gu32*)(ws + WS_CTL) + CW_CNT + 64 * l); }
            SEAM(p0 + 4);
        }
        if (IN(p0 + 5)) {
            for (int rep = 0; rep < REP_P6; ++rep) {
            unsigned char* ws = KWS(); LAS int* mt = (LAS int*)(F.lds + MOE_OFF); moe_build(mt, (gu32*)(ws + WS_CTL) + CW_CNT + 64 * l, opqs(F.wave) * 64 + cur_lane());
            pg8::Gemm g{(bf16*)(ws + WS_HB8), (bf16*)(ws + WS_WU8), T, 4 * DM, DM / 2, 0}; MoeOrder<1> S{mt, opqs(F.G), opqs(F.bx), mtu(mt, 56), (int*)(ws + WS_PERM)};
            EpiMoeUp E{mt, (float*)(ws + WS_DWP), (bf16*)(ws + WS_PA), (const float*)(ws + WS_CSU)};
            pg8::gemm_phase<EpiMoeUp, MoeOrder<1>, true, true, false, true>(F.lds, opqs(F.wave), g, S, E);
            if (l + 1 < DEPTH && rep + 1 == REP_P6) {
                const int G_ = opqs(F.G), nfull = mtu(mt, 56) * 2 > G_ ? (mtu(mt, 56) * 2 - G_ < G_ ? mtu(mt, 56) * 2 - G_ : G_ - 1) : 0, c_ = opqs(F.bx);
                if (c_ >= nfull) for (int s_ = c_ - nfull; s_ < 80; s_ += G_ - nfull) convert_strip_item(F, KWS(), l + 1, KIN(3), KIN(16), KIN(17), s_);
                convert_weights(F, KWS(), l + 1, KIN(3), KIN(10), KIN(11), KIN(16), KIN(17), KIN(18), KIN(6), 1, c_ >= nfull ? (c_ - nfull) * NWAVES + opqs(F.wave) : -1, (G_ - nfull) * NWAVES); } }
            SEAM(p0 + 5);
        }
        if (IN(p0 + 6)) {
            for (int rep = 0; rep < REP_P7; ++rep) {
            unsigned char* ws = KWS(); LAS int* mt = (LAS int*)(F.lds + MOE_OFF); moe_build(mt, (gu32*)(ws + WS_CTL) + CW_CNT + 64 * l, opqs(F.wave) * 64 + cur_lane());
            pg8::Gemm g{(bf16*)(ws + WS_PA), (bf16*)(ws + WS_WD), T + NBK * 256, 4 * DM, 256, 128}; MoeOrder<2> S{mt, opqs(F.G), opqs(F.bx), mtu(mt, 56), (int*)(ws + WS_PERM)};
            EpiMoeDown E{mt, (int*)(ws + WS_PERM), (bf16*)(ws + WS_HB), (bf16*)(ws + (rep + 1 < REP_P7 ? WS_PRE + 64 * MiB : WS_PRE))};
            pg8::gemm_phase<EpiMoeDown, MoeOrder<2>, true, false, true>(F.lds, opqs(F.wave), g, S, E); }
            SEAM(p0 + 6);
        }
        if (IN(p0 + 7)) {
            for (int rep = 0; rep < REP_P8; ++rep) { const bool dry = rep + 1 < REP_P8;
            { float* out = KOUT(); unsigned char* ws = KWS(); float* of = dry ? (float*)(ws + WS_PRE + 64 * MiB) : out; bf16* ob = (bf16*)(ws + (dry ? WS_PRE + 64 * MiB : WS_HB)); const bf16* pre = (const bf16*)(ws + WS_PRE);
              if (l + 1 < DEPTH) ln_phase_bf<false, true>(F, pre, KIN(19) + (size_t)l * DM, KIN(20) + (size_t)l * DM, of, ob, ws + WS_HB8, (float*)(ws + WS_RS)); else ln_phase_bf<true, false>(F, pre, KIN(19) + (size_t)l * DM, KIN(20) + (size_t)l * DM, of, ob, ws + WS_HB8, (float*)(ws + WS_RS)); } }
            SEAM(p0 + 7);
        }
    }
#undef IN
#undef SEAM
}

extern "C" void kernel_launch(void* const* d_in, const int* in_sizes, int n_in, void* d_out, int out_size, void* d_ws, size_t ws_size, hipStream_t stream) {
    static int grid = 0;
    if (grid == 0) {
        if (n_in != 21 || out_size != T * DM || ws_size < WS_END) { fprintf(stderr, "kernel_launch: unexpected shapes (n_in %d out %d ws %zu)\n", n_in, out_size, ws_size); grid = -1; return; }
        int dev = 0, cus = 0, per_cu = 0;
        if (hipGetDevice(&dev) != hipSuccess || hipDeviceGetAttribute(&cus, hipDeviceAttributeMultiprocessorCount, dev) != hipSuccess) { grid = -1; return; }
        if (hipFuncSetAttribute((const void*)fwd, hipFuncAttributeMaxDynamicSharedMemorySize, LDS_BYTES) != hipSuccess) { fprintf(stderr, "kernel_launch: hipFuncSetAttribute failed\n"); grid = -1; return; }
        if (hipOccupancyMaxActiveBlocksPerMultiprocessor(&per_cu, (const void*)fwd, NTHREADS, LDS_BYTES) != hipSuccess || per_cu < 1) fprintf(stderr, "kernel_launch: occupancy query says %d\n", per_cu);
        (void)hipGetLastError();
        if (cus < 256) { fprintf(stderr, "kernel_launch: this kernel is laid out for 256 resident workgroups (one per CU); the device reports %d CUs\n", cus); grid = -1; return; }
        grid = 256;
    }
    if (grid < 0) return;
    (void)hipMemsetAsync((char*)d_ws + WS_CTL, 0, CTL_ZERO_BYTES, stream);
    Args a{};
    for (int i = 0; i < 21; ++i) a.in[i] = (const float*)d_in[i];
    a.out = (float*)d_out; a.ws = (unsigned char*)d_ws;
#if MK_PER_PHASE
    for (int p = 0; p < NPH; ++p) { a.ph_lo = p; a.ph_hi = p + 1; hipLaunchKernelGGL(fwd, dim3(grid), dim3(NTHREADS), LDS_BYTES, stream, a); }
#else
    a.ph_lo = 0; a.ph_hi = NPH;
    hipLaunchKernelGGL(fwd, dim3(grid), dim3(NTHREADS), LDS_BYTES, stream, a);
#endif
}
```

```cpp
#include <hip/hip_runtime.h>
#include <cstdio>
#include <cstdint>

#ifndef MK_PER_PHASE
#define MK_PER_PHASE 0
#endif

#ifndef REP_P0
#define REP_P0 1
#define REP_P1 1
#define REP_P2 1
#define REP_P3 1
#define REP_P4 1
#define REP_P5 1
#define REP_P6 1
#define REP_P7 1
#define REP_P8 1
#define REP_BAR 1
#define REP_P2A 1
#define REP_P2B 1
#define REP_P2C 1
#endif
#define GAS __attribute__((address_space(1)))
#define LAS __attribute__((address_space(3)))
typedef unsigned short bf16;
typedef short bf16x8 __attribute__((ext_vector_type(8)));
typedef float f32x4 __attribute__((ext_vector_type(4)));
typedef float f32x2 __attribute__((ext_vector_type(2)));
typedef float f32x16 __attribute__((ext_vector_type(16)));
typedef unsigned u32x4 __attribute__((ext_vector_type(4)));
typedef unsigned u32x2 __attribute__((ext_vector_type(2)));
typedef GAS unsigned gu32;

constexpr int DM = 1024, BATCH = 2, SEQ = 16384, T = BATCH * SEQ, DEPTH = 4, INC = 5120;
constexpr float ALPHA = 1.6817928305074292f;
constexpr float LN_EPS = 1e-5f;
constexpr int NWAVES = 8, NTHREADS = 512;
constexpr int NPH = 1 + 8 * DEPTH;

constexpr size_t MiB = 1u << 20;
constexpr size_t WS_CTL = 0, CTL_ZERO_BYTES = 1 * MiB;
constexpr size_t WS_WIN = 1 * MiB;
constexpr size_t WS_WBR = 11 * MiB;
constexpr size_t WS_WO = 13 * MiB;
constexpr size_t WS_WGU = 15 * MiB;
constexpr size_t WS_WD = 23 * MiB;
constexpr size_t WS_SGW = 27 * MiB;
constexpr size_t WS_PERM = 416 * MiB;
constexpr size_t WS_DWP = 420 * MiB;
constexpr size_t WS_HB = 32 * MiB;
constexpr size_t WS_PA = 96 * MiB;
constexpr size_t WS_Q = 144 * MiB;
constexpr size_t WS_MG = 144 * MiB;
constexpr size_t WS_K = 160 * MiB;
constexpr size_t WS_VT = 176 * MiB;
constexpr size_t WS_UC = 192 * MiB;
constexpr size_t WS_GATE = 224 * MiB;
constexpr size_t WS_PRE = 224 * MiB;
constexpr size_t WS_Y = 416 * MiB;
constexpr size_t WS_HB8 = 464 * MiB;
constexpr size_t WS_RS = 496 * MiB;
constexpr size_t WS_WG8 = 497 * MiB;
constexpr size_t WS_CS = 502 * MiB;
constexpr size_t WS_WU8 = 503 * MiB;
constexpr size_t WS_CSU = 507 * MiB;
constexpr size_t WS_END = 508 * MiB;

constexpr int CW_TMO = 0, CW_CODE = 1, CW_BAR = 4096, CW_CNT = 8192;

constexpr int RING_BYTES = 131072, ROWTAB_OFF = RING_BYTES, ROWTAB_BYTES = 8192, LDSCTL_OFF = ROWTAB_OFF + ROWTAB_BYTES, MISC_OFF = LDSCTL_OFF + 320, MOE_OFF = MISC_OFF + 192, SIGT_OFF = MOE_OFF + 256;
constexpr int SIGT_N = 2048;
constexpr int LDS_BYTES = 147456;

__device__ __forceinline__ unsigned cvt_pk_bf16(float lo, float hi) { unsigned r; asm volatile("v_cvt_pk_bf16_f32 %0, %1, %2" : "=v"(r) : "v"(lo), "v"(hi)); return r; }
__device__ __forceinline__ float bf_lo(unsigned u) { return __uint_as_float(u << 16); }
__device__ __forceinline__ float bf_hi(unsigned u) { return __uint_as_float(u & 0xffff0000u); }
__device__ __forceinline__ float shfl_xor_l(float v, int mask, int lane) { return __int_as_float(__builtin_amdgcn_ds_bpermute((lane ^ mask) << 2, __float_as_int(v))); }
typedef int i32x4 __attribute__((ext_vector_type(4)));
__device__ __forceinline__ int q8(float x) { return (int)__builtin_rintf(__builtin_amdgcn_fmed3f(x, -127.f, 127.f)); }
__device__ __forceinline__ unsigned pack4_i8(int a, int b, int c, int d) { return (unsigned)(a & 0xff) | ((unsigned)(b & 0xff) << 8) | ((unsigned)(c & 0xff) << 16) | ((unsigned)d << 24); }
template <int CTRL> __device__ __forceinline__ float dpp_f(float v) { return __int_as_float(__builtin_amdgcn_update_dpp(0, __float_as_int(v), CTRL, 0xf, 0xf, true)); }
__device__ __forceinline__ float wave_sum(float v, int lane) {
    (void)lane;
    v += dpp_f<0xB1>(v);
    v += dpp_f<0x4E>(v);
    v += dpp_f<0x141>(v);
    v += dpp_f<0x140>(v);
    const int iv = __float_as_int(v);
    const float a = __int_as_float(__builtin_amdgcn_readlane(iv, 0)), b = __int_as_float(__builtin_amdgcn_readlane(iv, 16)), c = __int_as_float(__builtin_amdgcn_readlane(iv, 32)), d = __int_as_float(__builtin_amdgcn_readlane(iv, 48));
    return (a + b) + (c + d);
}
__device__ __forceinline__ float sigmoid_fast(float x) { return __builtin_amdgcn_rcpf(1.f + __builtin_amdgcn_exp2f(-1.4426950409f * x)); }
__device__ __forceinline__ float gelu_tanh(float x) { const float u = x * (1.f + 0.044715f * x * x); return x * __builtin_amdgcn_rcpf(1.f + __builtin_amdgcn_exp2f(-2.302208198f * u)); }
#define LDS_WAIT() asm volatile("s_waitcnt lgkmcnt(0)" ::: "memory")
#define VM_WAIT() asm volatile("s_waitcnt vmcnt(0)" ::: "memory")
#define RLX_AGENT __ATOMIC_RELAXED, __HIP_MEMORY_SCOPE_AGENT

__device__ __forceinline__ int opq(int v) { asm volatile("" : "+v"(v)); return v; }
__device__ __forceinline__ int opqs(int v) { asm volatile("" : "+s"(v)); return v; }
__device__ __forceinline__ int cur_lane() { int l; asm volatile("v_mbcnt_lo_u32_b32 %0, -1, 0\n\tv_mbcnt_hi_u32_b32 %0, -1, %0" : "=v"(l)); return l; }
__device__ __forceinline__ void glds16(const void* gsrc, unsigned lds_dst) { unsigned keep;
    asm volatile("s_mov_b32 %0, m0\n\ts_mov_b32 m0, %2\n\ts_nop 0\n\tglobal_load_lds_dwordx4 %1, off\n\ts_mov_b32 m0, %0" : "=&s"(keep) : "v"(gsrc), "s"(lds_dst) : "memory"); }
__device__ __forceinline__ float wave_max(float v) {
    v = fmaxf(v, dpp_f<0xB1>(v)); v = fmaxf(v, dpp_f<0x4E>(v)); v = fmaxf(v, dpp_f<0x141>(v)); v = fmaxf(v, dpp_f<0x140>(v));
    const int iv = __float_as_int(v);
    return fmaxf(fmaxf(__int_as_float(__builtin_amdgcn_readlane(iv, 0)), __int_as_float(__builtin_amdgcn_readlane(iv, 16))), fmaxf(__int_as_float(__builtin_amdgcn_readlane(iv, 32)), __int_as_float(__builtin_amdgcn_readlane(iv, 48))));
}
namespace pg8 {
#define PG8_LAS __attribute__((address_space(3)))
typedef unsigned short bf16_t;
constexpr int BM = 256, BK = 64, HALF = 128, HTB = HALF * BK * 2, STAGE_BYTES = 8 * HTB, NXCD = 8, WGM = 8, MAXU = 8;

__host__ __device__ __forceinline__ int lds_byte(int r, int c) { const int st = (r >> 4) * 2 + (c >> 5), rr = r & 15, cc = c & 31, ob = rr * 64 + cc * 2; return st * 1024 + (ob ^ (((ob >> 9) & 1) << 5)); }
__host__ __device__ __forceinline__ void stage_rc(int b, int& R, int& C) { const int st = b / 1024, sb = b % 1024, swz = sb ^ (((sb >> 9) & 1) << 5); R = (st >> 1) * 16 + swz / 64; C = (st & 1) * 32 + (swz % 64) / 2; }
__host__ __device__ __forceinline__ int perm32(int rho) { const int n = rho >> 4, i = rho & 15; return 8 * (i >> 2) + 4 * n + (i & 3); }

struct Unit { int pm, pn, pn2, aux; };
struct Gemm { const bf16_t* A; const bf16_t* Bt; int M, N, K, ldb; };

struct StaticOrder {
    int nM, nN, nwg, G, c;
    __host__ __device__ void init(int M, int N, int G_, int c_) { nM = M / BM; nN = N / BM; nwg = nM * nN; G = G_; c = c_; }
    __host__ __device__ bool next(int i, Unit& u) const {
        const long L = (long)i * G + c; if (L >= nwg) return false;
        int wgid = (int)L; { const int q = nwg / NXCD, r = nwg % NXCD, xcd = wgid % NXCD, off = wgid / NXCD; wgid = (xcd < r ? xcd * (q + 1) : r * (q + 1) + (xcd - r) * q) + off; }
        const int nig = WGM * nN, gid = wgid / nig, fm = gid * WGM, gsz = (nM - fm) < WGM ? (nM - fm) : WGM;
        u.pm = fm + ((wgid % nig) % gsz); u.pn = (wgid % nig) / gsz; u.pn2 = 0; u.aux = 0; return true;
    }
    __device__ __forceinline__ int arow(const Unit&, int) const { return 0; }
    __device__ __forceinline__ void a_ready(const Unit&) const {}
    __device__ __forceinline__ void done(const Unit&) const {}
};

template <class Epi, class Sched, bool ALIGN_EPI, bool GATHER, bool SPLITB = false, bool I8 = false>
__device__ __forceinline__ void gemm_phase(PG8_LAS unsigned char* lds, const int wid, const Gemm g, const Sched& S, const Epi& E) {
    const int lane = cur_lane(), tid = wid * 64 + lane, wr = wid >> 2, wc = wid & 3, fr = lane & 15, fq = lane >> 4;
    const int K = g.K, nt = K / BK, ldb = g.ldb ? g.ldb : K;
    unsigned voffA[2], voffB[2]; int Rr[2], Cc[2];
#pragma unroll
    for (int i = 0; i < 2; ++i) { int R, C; stage_rc(tid * 16 + i * 8192, R, C); const int Rb = Epi::PERM ? ((R & ~31) + perm32(R & 31)) : R;
        Rr[i] = R; Cc[i] = C; voffA[i] = (unsigned)(R * K + C) * 2u; voffB[i] = (unsigned)(Rb * ldb + C) * 2u; }
    const size_t kstep = (size_t)(BK * 2);
    const size_t hstep = (size_t)HALF * K * 2;
    const size_t tstep = 2 * hstep;
    const size_t hstepB = (size_t)HALF * ldb * 2, tstepB = 2 * hstepB;
    const unsigned ldsb = (unsigned)(unsigned long long)lds + (unsigned)wid * 1024u;
    const int aoff = lds_byte(wr * 64 + fr, fq * 8), boff = lds_byte(wc * 32 + fr, fq * 8);
#define PG8_SA(b, h) (((b) * 2 + (h)) * HTB)
#define PG8_SB(b, h) ((4 + (b) * 2 + (h)) * HTB)
#define PG8_STAGE(bufoff, gbase, voff) do { _Pragma("unroll") for (int _i = 0; _i < 2; ++_i) \
        glds16((const char*)(gbase) + (voff)[_i], ldsb + (unsigned)((bufoff) + _i * 8192)); } while (0)
#define PG8_STAGE_A(bufoff, kp, h, vs) do { if constexpr (GATHER) { PG8_STAGE(bufoff, kp, vs[h]); } else { PG8_STAGE(bufoff, (kp) + (h) * hstep, voffA); } } while (0)
#define PG8_LDA(dst, b, h) do { _Pragma("unroll") for (int m = 0; m < 4; ++m) _Pragma("unroll") for (int k = 0; k < 2; ++k) dst[m][k] = *(const PG8_LAS bf16x8*)(lds + PG8_SA(b, h) + aoff + m * 2048 + k * 1024); } while (0)
#define PG8_LDB(dst, b, h) do { _Pragma("unroll") for (int n = 0; n < 2; ++n) _Pragma("unroll") for (int k = 0; k < 2; ++k) dst[n][k] = *(const PG8_LAS bf16x8*)(lds + PG8_SB(b, h) + boff + n * 2048 + k * 1024); } while (0)
#define PG8_MMA(ai, bj, At, Bt) do { __builtin_amdgcn_s_setprio(1); _Pragma("unroll") for (int m = 0; m < 4; ++m) _Pragma("unroll") for (int n = 0; n < 2; ++n) _Pragma("unroll") for (int k = 0; k < 2; ++k) \
        { if constexpr (I8) acc[ai][bj][m][n] = __builtin_bit_cast(f32x4, __builtin_amdgcn_mfma_i32_16x16x64_i8(__builtin_bit_cast(i32x4, Bt[n][k]), __builtin_bit_cast(i32x4, At[m][k]), __builtin_bit_cast(i32x4, acc[ai][bj][m][n]), 0, 0, 0)); \
          else acc[ai][bj][m][n] = __builtin_amdgcn_mfma_f32_16x16x32_bf16(Bt[n][k], At[m][k], acc[ai][bj][m][n], 0, 0, 0); } __builtin_amdgcn_s_setprio(0); } while (0)
#define PG8_WAIT_V(n) asm volatile("s_waitcnt vmcnt(" #n ")" ::: "memory")
#define PG8_WAIT_L(n) asm volatile("s_waitcnt lgkmcnt(" #n ")" ::: "memory")
#define PG8_BAR __builtin_amdgcn_s_barrier()
#define PG8_SCHED __builtin_amdgcn_sched_barrier(0)
    Unit cur, nxt; int ui = 0;
    if (!S.next(0, cur)) return;
    PG8_LAS int* rowtab = (PG8_LAS int*)(lds + STAGE_BYTES);
    unsigned vAc[2][2], vAn[2][2], vS[2][2];
    if constexpr (GATHER) {
        Unit uu;
        for (int i = 0; i < MAXU; ++i) { if (!S.next(i, uu)) break; if (tid < 256) rowtab[i * 256 + tid] = S.arow(uu, tid); }
        asm volatile("s_waitcnt vmcnt(0) lgkmcnt(0)" ::: "memory"); __builtin_amdgcn_s_barrier(); asm volatile("" ::: "memory");
#pragma unroll
        for (int h = 0; h < 2; ++h)
#pragma unroll
            for (int i = 0; i < 2; ++i) { vAc[h][i] = (unsigned)(rowtab[h * 128 + Rr[i]] * K + Cc[i]) * 2u; vAn[h][i] = vAc[h][i]; vS[h][i] = vAc[h][i]; }
    }
    f32x4 acc[2][2][4][2];
#pragma unroll
    for (int a = 0; a < 2; ++a)
#pragma unroll
        for (int b = 0; b < 2; ++b)
#pragma unroll
            for (int m = 0; m < 4; ++m)
#pragma unroll
                for (int n = 0; n < 2; ++n) acc[a][b][m][n] = (f32x4){0.f, 0.f, 0.f, 0.f};
    bf16x8 At[4][2], B0[2][2], B1[2][2];
    const char* cA = GATHER ? (const char*)g.A : (const char*)g.A + (size_t)cur.pm * tstep; const char* cB = (const char*)g.Bt + (size_t)cur.pn * tstepB; const char* cB2 = (const char*)g.Bt + (size_t)cur.pn2 * tstepB;
    S.a_ready(cur);
    PG8_STAGE(PG8_SB(0, 0), cB, voffB); PG8_STAGE(PG8_SB(0, 1), cB + hstepB, voffB); PG8_STAGE_A(PG8_SA(0, 0), cA, 0, vAc); PG8_STAGE_A(PG8_SA(0, 1), cA, 1, vAc);
    if (wr == 1) PG8_BAR;
    PG8_WAIT_V(2); PG8_BAR;
    PG8_STAGE(PG8_SB(1, 0), cB + kstep, voffB); PG8_STAGE_A(PG8_SA(1, 0), cA + kstep, 0, vAc); PG8_STAGE(PG8_SB(1, 1), cB + hstepB + kstep, voffB);
    PG8_WAIT_V(6); PG8_BAR;
    for (;;) {
        const bool has_next = S.next(ui + 1, nxt);
        const char* nA = GATHER ? cA : (has_next ? (const char*)g.A + (size_t)nxt.pm * tstep : cA); const char* nB = has_next ? (const char*)g.Bt + (size_t)nxt.pn * tstepB : cB; const char* nB2 = has_next ? (const char*)g.Bt + (size_t)nxt.pn2 * tstepB : cB2;
        if constexpr (GATHER) {
            if (has_next) {
#pragma unroll
                for (int h = 0; h < 2; ++h)
#pragma unroll
                    for (int i = 0; i < 2; ++i) vAn[h][i] = (unsigned)(rowtab[(ui + 1) * 256 + h * 128 + Rr[i]] * K + Cc[i]) * 2u;
            }
        }
        for (int t = 0; t < nt; t += 2) {
            const bool last = (t == nt - 2);
            const char* a1 = cA + (size_t)(t + 1) * kstep;
            const char* a2 = last ? nA : cA + (size_t)(t + 2) * kstep; const char* b2 = last ? nB : (SPLITB ? cB2 : cB + (size_t)(t + 2) * kstep);
            const char* a3 = a2 + kstep; const char* b3 = b2 + kstep;
            if constexpr (GATHER) {
#pragma unroll
                for (int h = 0; h < 2; ++h)
#pragma unroll
                    for (int i = 0; i < 2; ++i) vS[h][i] = last ? vAn[h][i] : vAc[h][i];
            }
            if (last && has_next) S.a_ready(nxt);
            PG8_LDB(B0, 0, 0); PG8_LDB(B1, 0, 1); PG8_SCHED; PG8_LDA(At, 0, 0); PG8_STAGE_A(PG8_SA(1, 1), a1, 1, vAc);
            PG8_WAIT_V(8); PG8_WAIT_L(0); PG8_BAR; PG8_MMA(0, 0, At, B0); PG8_MMA(0, 1, At, B1); PG8_BAR; PG8_SCHED;
            PG8_LDA(At, 0, 1); PG8_STAGE(PG8_SB(0, 0), b2, voffB); PG8_STAGE(PG8_SB(0, 1), b2 + hstepB, voffB); PG8_STAGE_A(PG8_SA(0, 0), a2, 0, vS);
            PG8_WAIT_V(8); PG8_WAIT_L(0); PG8_BAR; PG8_MMA(1, 0, At, B0); PG8_MMA(1, 1, At, B1); PG8_BAR; PG8_SCHED;
            PG8_LDB(B0, 1, 0); PG8_LDB(B1, 1, 1); PG8_SCHED; PG8_LDA(At, 1, 0); PG8_STAGE_A(PG8_SA(0, 1), a2, 1, vS);
            PG8_WAIT_V(8); PG8_WAIT_L(0); PG8_BAR; PG8_MMA(0, 0, At, B0); PG8_MMA(0, 1, At, B1); PG8_BAR; PG8_SCHED;
            PG8_LDA(At, 1, 1); PG8_STAGE(PG8_SB(1, 0), b3, voffB); PG8_STAGE(PG8_SB(1, 1), b3 + hstepB, voffB); PG8_STAGE_A(PG8_SA(1, 0), a3, 0, vS);
            PG8_WAIT_V(8); PG8_WAIT_L(0); PG8_BAR; PG8_MMA(1, 0, At, B0); PG8_MMA(1, 1, At, B1); PG8_BAR; PG8_SCHED;
        }
        if constexpr (ALIGN_EPI) { if (wr == 0) PG8_BAR; }
        E(acc, cur, wr, wc, fr, fq); S.done(cur);
        if (!has_next) break;
        if (!E.keep(cur))
#pragma unroll
        for (int a = 0; a < 2; ++a)
#pragma unroll
            for (int b = 0; b < 2; ++b)
#pragma unroll
                for (int m = 0; m < 4; ++m)
#pragma unroll
                    for (int n = 0; n < 2; ++n) acc[a][b][m][n] = (f32x4){0.f, 0.f, 0.f, 0.f};
        cur = nxt; cA = nA; cB = nB; cB2 = nB2; ++ui;
        if constexpr (GATHER) {
#pragma unroll
            for (int h = 0; h < 2; ++h)
#pragma unroll
                for (int i = 0; i < 2; ++i) vAc[h][i] = vAn[h][i];
        }
        if constexpr (ALIGN_EPI) { if (wr == 1) PG8_BAR; }
    }
    PG8_WAIT_V(0);
    if constexpr (!ALIGN_EPI) { if (wr == 0) PG8_BAR; }
    PG8_BAR;
#undef PG8_SA
#undef PG8_SB
#undef PG8_STAGE
#undef PG8_STAGE_A
#undef PG8_LDA
#undef PG8_LDB
#undef PG8_MMA
#undef PG8_WAIT_V
#undef PG8_WAIT_L
#undef PG8_BAR
#undef PG8_SCHED
}
}

#define XB_TMO      128
#define XB_XCNT(j)  (256  + 64 * (j))
#define XB_XSUB(j)  (1280 + 64 * (j))
#define XB_XGEN(j)  (2304 + 64 * (j))
#define XB_TOP      3328
#define XB_TOPGEN   3392
#define XCD_BAR_WORDS 3456
#define XB_SPIN_CAP (1u << 18)

__device__ __forceinline__ unsigned xb_ld(unsigned* p)              { return __hip_atomic_load(p, __ATOMIC_RELAXED, __HIP_MEMORY_SCOPE_AGENT); }
__device__ __forceinline__ unsigned xb_add(unsigned* p, unsigned v) { return __hip_atomic_fetch_add(p, v, __ATOMIC_RELAXED, __HIP_MEMORY_SCOPE_AGENT); }
__device__ __forceinline__ unsigned xb_xcc_id() { return (unsigned)__builtin_amdgcn_s_getreg((3 << 11) | 20) & 0xFu; }
#define XB_SPIN(cond, bar) do { unsigned _sp = 0; while (cond) { __builtin_amdgcn_s_sleep(1); \
    if ((++_sp & 255u) == 0u) { if (xb_ld(&(bar)[XB_TMO])) break; if (_sp > XB_SPIN_CAP) { atomicAdd(&(bar)[XB_TMO], 1u); break; } } } } while (0)

struct XcdBarrier {
    unsigned* bar; unsigned x;
    volatile LAS unsigned* st;
};
__device__ __forceinline__ XcdBarrier xcd_barrier_post(unsigned* bar, volatile LAS unsigned* st) {
    XcdBarrier b; b.bar = bar; b.x = xb_xcc_id(); b.st = st;
    if (threadIdx.x == 0) (void)xb_add(&bar[XB_XCNT(b.x)], 1u);
    return b;
}
__device__ __forceinline__ void xcd_barrier_complete(unsigned* bar, unsigned x, unsigned& nloc, unsigned& nx) {
    const unsigned G = gridDim.x * gridDim.y * gridDim.z;
    unsigned sum, cnt, mine, sp = 0u;
    for (;;) {
        sum = 0u; cnt = 0u; mine = 0u;
#pragma unroll
        for (unsigned j = 0; j < 16; ++j) { const unsigned c = xb_ld(&bar[XB_XCNT(j)]); sum += c; cnt += (c > 0u) ? 1u : 0u; mine = (j == x) ? c : mine; }
        if (sum == G) break;
        __builtin_amdgcn_s_sleep(1);
        if ((++sp & 255u) == 0u) { if (xb_ld(&bar[XB_TMO])) break; if (sp > XB_SPIN_CAP) { atomicAdd(&bar[XB_TMO], 1u); break; } }
    }
    nloc = mine > 0u ? mine : 1u; nx = cnt > 0u ? cnt : 1u;
}
__device__ __forceinline__ void xcd_barrier(const XcdBarrier& b, const bool thread0) {
    asm volatile("s_waitcnt vmcnt(0)" ::: "memory");
    __syncthreads();
    if (thread0) {
        unsigned* bar = b.bar;
        __builtin_amdgcn_s_waitcnt(0);
        unsigned nloc = b.st[0], nx = b.st[1];
        if (nloc == 0u) { xcd_barrier_complete(bar, b.x, nloc, nx); b.st[0] = nloc; b.st[1] = nx; }
        const unsigned old = xb_add(&bar[XB_XSUB(b.x)], 1u);
        const unsigned gen = old / nloc;
        if (old + 1u == (gen + 1u) * nloc) {
            __builtin_amdgcn_fence(__ATOMIC_RELEASE, "agent");
            asm volatile("s_waitcnt vmcnt(0)" ::: "memory");
            const unsigned og = xb_add(&bar[XB_TOP], 1u);
            const unsigned tg = og / nx;
            if (og + 1u == (tg + 1u) * nx) xb_add(&bar[XB_TOPGEN], 1u);
            else XB_SPIN(xb_ld(&bar[XB_TOPGEN]) == tg, bar);
            __builtin_amdgcn_fence(__ATOMIC_ACQUIRE, "agent");
            xb_add(&bar[XB_XGEN(b.x)], 1u);
            asm volatile("s_waitcnt vmcnt(0)" ::: "memory");
        } else {
            XB_SPIN(xb_ld(&bar[XB_XGEN(b.x)]) == gen, bar);
            __builtin_amdgcn_fence(__ATOMIC_ACQUIRE, "agent");
            asm volatile("s_waitcnt vmcnt(0)" ::: "memory");
        }
    }
    __syncthreads();
}

using pg8::Unit;
struct EpiProj {
    static constexpr bool PERM = true;
    __device__ __forceinline__ bool keep(const Unit&) const { return false; }
    bf16 *PA, *Q, *Kb, *UC; unsigned char* GATE; const float* bgate; const LAS unsigned char* sigt; const float* rs; const float* cs;
    __device__ __forceinline__ void operator()(f32x4 (&acc)[2][2][4][2], const Unit& u, int wr, int wc, int fr, int fq) const {
        const int pn = u.pn; bf16* dst; int ldc, cb, act;
        if (pn < 3) { dst = PA; ldc = 768; cb = pn * 256; act = 0; }
        else if (pn == 3) { dst = Q; ldc = 256; cb = 0; act = 3; }
        else if (pn == 4) { dst = Kb; ldc = 256; cb = 0; act = 0; }
        else if (pn < 8) { dst = UC; ldc = 512; cb = (pn - 6) * 256; act = 1; }
        else { dst = PA; ldc = 0; cb = (pn - 8) * 256; act = 2; }
        const int row0 = u.pm * 256 + wr * 64 + fr, col0 = cb + wc * 32 + 8 * fq;
        unsigned char* gblk = GATE + ((size_t)(u.pm * 12 + (pn - 8)) << 16) + ((((wr * 4 + wc) * 4 + fq) * 16 + fr) << 3);
        f32x4 bv[2][2];
#pragma unroll
        for (int bj = 0; bj < 2; ++bj)
#pragma unroll
            for (int n = 0; n < 2; ++n) bv[bj][n] = *(const f32x4*)(bgate + (act == 2 ? col0 : 0) + bj * 128 + 4 * n);
#pragma unroll
        for (int ai = 0; ai < 2; ++ai)
#pragma unroll
            for (int m = 0; m < 4; ++m) { bf16* rowp = dst + (size_t)(row0 + ai * 128 + m * 16) * ldc + col0;
#pragma unroll
                for (int bj = 0; bj < 2; ++bj) { const i32x4 i0 = __builtin_bit_cast(i32x4, acc[ai][bj][m][0]), i1 = __builtin_bit_cast(i32x4, acc[ai][bj][m][1]); const float rsv = rs[row0 + ai * 128 + m * 16];
                    const f32x4 c0 = *(const f32x4*)(cs + u.pn * 256 + wc * 32 + 8 * fq + bj * 128), c1 = *(const f32x4*)(cs + u.pn * 256 + wc * 32 + 8 * fq + bj * 128 + 4);
                    f32x4 v0 = (f32x4){(float)i0[0], (float)i0[1], (float)i0[2], (float)i0[3]} * c0 * rsv, v1 = (f32x4){(float)i1[0], (float)i1[1], (float)i1[2], (float)i1[3]} * c1 * rsv;
                    if (act == 1) {
#pragma unroll
                        for (int j = 0; j < 4; ++j) { v0[j] = gelu_tanh(v0[j]); v1[j] = gelu_tanh(v1[j]); }
                    } else if (act == 2) { v0 = v0 + bv[bj][0]; v1 = v1 + bv[bj][1]; unsigned q[8];
#pragma unroll
                        for (int j = 0; j < 4; ++j) { q[j] = sigt[(int)__builtin_amdgcn_fmed3f(v0[j] * 128.f + 1024.f, 0.f, 2047.f)]; q[4 + j] = sigt[(int)__builtin_amdgcn_fmed3f(v1[j] * 128.f + 1024.f, 0.f, 2047.f)]; }
                        u32x2 w8; w8.x = q[0] | (q[1] << 8) | (q[2] << 16) | (q[3] << 24); w8.y = q[4] | (q[5] << 8) | (q[6] << 16) | (q[7] << 24);
                        *(u32x2*)(gblk + ((((ai * 4 + m) * 2 + bj)) << 12)) = w8; continue;
                    } else if (act == 3) { v0 = v0 * 0.18033688f; v1 = v1 * 0.18033688f; }
                    u32x4 w; w.x = cvt_pk_bf16(v0[0], v0[1]); w.y = cvt_pk_bf16(v0[2], v0[3]); w.z = cvt_pk_bf16(v1[0], v1[1]); w.w = cvt_pk_bf16(v1[2], v1[3]);
                    *(u32x4*)(rowp + bj * 128) = w; } }
        asm volatile("" :: "v"(bv[0][0]), "v"(bv[0][1]), "v"(bv[1][0]), "v"(bv[1][1]));
    }
};
struct EpiGate {
    static constexpr bool PERM = true;
    __device__ __forceinline__ bool keep(const Unit&) const { return false; }
    unsigned char* GATE; const float* bgate; const float* rs; const float* cs; const LAS unsigned char* sigt;
    __device__ __forceinline__ void operator()(f32x4 (&acc)[2][2][4][2], const Unit& u, int wr, int wc, int fr, int fq) const {
        const int row0 = u.pm * 256 + wr * 64 + fr, col0 = u.pn * 256 + wc * 32 + 8 * fq;
        unsigned char* gblk = GATE + ((size_t)(u.pm * 12 + u.pn) << 16) + ((((wr * 4 + wc) * 4 + fq) * 16 + fr) << 3);
        f32x4 bv[2][2], cv[2][2]; float rv[2][4];
#pragma unroll
        for (int bj = 0; bj < 2; ++bj)
#pragma unroll
            for (int n = 0; n < 2; ++n) { bv[bj][n] = *(const f32x4*)(bgate + col0 + bj * 128 + 4 * n); cv[bj][n] = *(const f32x4*)(cs + col0 + bj * 128 + 4 * n); }
#pragma unroll
        for (int ai = 0; ai < 2; ++ai)
#pragma unroll
            for (int m = 0; m < 4; ++m) rv[ai][m] = rs[row0 + ai * 128 + m * 16];
#pragma unroll
        for (int ai = 0; ai < 2; ++ai)
#pragma unroll
            for (int m = 0; m < 4; ++m)
#pragma unroll
                for (int bj = 0; bj < 2; ++bj) { const i32x4 i0 = __builtin_bit_cast(i32x4, acc[ai][bj][m][0]), i1 = __builtin_bit_cast(i32x4, acc[ai][bj][m][1]); unsigned q[8];
#pragma unroll
                    for (int j = 0; j < 4; ++j) { const float v0 = (float)i0[j] * (rv[ai][m] * cv[bj][0][j]) + bv[bj][0][j], v1 = (float)i1[j] * (rv[ai][m] * cv[bj][1][j]) + bv[bj][1][j];
                        q[j] = sigt[(int)__builtin_amdgcn_fmed3f(v0 * 128.f + 1024.f, 0.f, 2047.f)]; q[4 + j] = sigt[(int)__builtin_amdgcn_fmed3f(v1 * 128.f + 1024.f, 0.f, 2047.f)]; }
                    u32x2 w8; w8.x = q[0] | (q[1] << 8) | (q[2] << 16) | (q[3] << 24); w8.y = q[4] | (q[5] << 8) | (q[6] << 16) | (q[7] << 24);
                    *(u32x2*)(gblk + ((((ai * 4 + m) * 2 + bj)) << 12)) = w8; }
    }
};
struct EpiVt {
    static constexpr bool PERM = true;
    __device__ __forceinline__ bool keep(const Unit&) const { return false; }
    bf16* VT; const float* rs; const float* cs;
    __device__ __forceinline__ void operator()(f32x4 (&acc)[2][2][4][2], const Unit& u, int wr, int wc, int fr, int fq) const {
        const int row0 = wr * 64 + fr, col0 = u.pn * 256 + wc * 32 + 8 * fq;
#pragma unroll
        for (int ai = 0; ai < 2; ++ai)
#pragma unroll
            for (int m = 0; m < 4; ++m) { const int dg = row0 + ai * 128 + m * 16;
                bf16* rowp = VT + ((size_t)(dg >> 6) * (T / 32) * 64 + (dg & 63)) * 32 + (size_t)(col0 >> 5) * 2048 + (col0 & 31);
#pragma unroll
                for (int bj = 0; bj < 2; ++bj) { const i32x4 i0 = __builtin_bit_cast(i32x4, acc[ai][bj][m][0]), i1 = __builtin_bit_cast(i32x4, acc[ai][bj][m][1]); const float csv = cs[1280 + dg];
                    const f32x4 r0 = *(const f32x4*)(rs + col0 + bj * 128), r1 = *(const f32x4*)(rs + col0 + bj * 128 + 4);
                    const f32x4 v0 = (f32x4){(float)i0[0], (float)i0[1], (float)i0[2], (float)i0[3]} * r0 * csv, v1 = (f32x4){(float)i1[0], (float)i1[1], (float)i1[2], (float)i1[3]} * r1 * csv;
                    u32x4 w; w.x = cvt_pk_bf16(v0[0], v0[1]); w.y = cvt_pk_bf16(v0[2], v0[3]); w.z = cvt_pk_bf16(v1[0], v1[1]); w.w = cvt_pk_bf16(v1[2], v1[3]);
                    *(u32x4*)(rowp + bj * 4 * 2048) = w; } }
    }
};
struct EpiMerge {
    static constexpr bool PERM = true;
    const unsigned char* GATE; bf16* MG;
    __device__ __forceinline__ bool keep(const Unit& u) const { return (u.pn >> 2) < 2; }
    __device__ __forceinline__ void operator()(f32x4 (&acc)[2][2][4][2], const Unit& u, int wr, int wc, int fr, int fq) const {
        const int br = u.pn >> 2, pm = u.pm - br * (T / 256), pn = u.pn & 3;
        const int row0 = pm * 256 + wr * 64 + fr, col0 = pn * 256 + wc * 32 + 8 * fq;
        const unsigned char* gbase = GATE + ((size_t)(pm * 12 + br * 4 + pn) << 16) + ((((wr * 4 + wc) * 4 + fq) * 16 + fr) << 3); const int gnext = br < 2 ? (4 << 16) : 0;
        u32x2 ga[4][2][2], gb[4][2][2];
#define EM_LOAD(hb) do { _Pragma("unroll") for (int mm = 0; mm < 2; ++mm) _Pragma("unroll") for (int bj = 0; bj < 2; ++bj) { \
            const unsigned char* gp = gbase + ((((((hb) >> 1) * 4 + 2 * ((hb) & 1) + mm) * 2 + bj)) << 12); \
            ga[hb][mm][bj] = *(const u32x2*)gp; gb[hb][mm][bj] = *(const u32x2*)(gp + gnext); } asm volatile("" ::: "memory"); } while (0)
#define EM_COMP(hb) do { _Pragma("unroll") for (int mm = 0; mm < 2; ++mm) _Pragma("unroll") for (int bj = 0; bj < 2; ++bj) { \
            constexpr int ai = (hb) >> 1; const int m = 2 * ((hb) & 1) + mm; const u32x2 a = ga[hb][mm][bj], b = gb[hb][mm][bj]; float s[8]; \
            _Pragma("unroll") for (int q = 0; q < 8; ++q) { float av = (float)((a[q >> 2] >> (8 * (q & 3))) & 0xffu); const float bv_ = (float)((b[q >> 2] >> (8 * (q & 3))) & 0xffu); \
                if (br > 0) av = fmaxf(av, 1.f);                        \
                if (br < 2) av *= __builtin_amdgcn_rcpf(fmaxf(bv_, 1.f)); else av *= (1.f / 255.f); \
                s[q] = av; } \
            f32x4 v0 = acc[ai][bj][m][0], v1 = acc[ai][bj][m][1]; \
            v0[0] *= s[0]; v0[1] *= s[1]; v0[2] *= s[2]; v0[3] *= s[3]; v1[0] *= s[4]; v1[1] *= s[5]; v1[2] *= s[6]; v1[3] *= s[7]; \
            if (br < 2) { acc[ai][bj][m][0] = v0; acc[ai][bj][m][1] = v1; } \
            else { u32x4 w; w.x = cvt_pk_bf16(v0[0], v0[1]); w.y = cvt_pk_bf16(v0[2], v0[3]); w.z = cvt_pk_bf16(v1[0], v1[1]); w.w = cvt_pk_bf16(v1[2], v1[3]); \
                *(u32x4*)(MG + (size_t)(row0 + ai * 128 + m * 16) * 1024 + col0 + bj * 128) = w; } } asm volatile("" ::: "memory"); } while (0)
        EM_LOAD(0); EM_LOAD(1); EM_COMP(0); EM_LOAD(2); EM_COMP(1); EM_LOAD(3); EM_COMP(2); EM_COMP(3);
#undef EM_LOAD
#undef EM_COMP
    }
};
struct EpiWo {
    static constexpr bool PERM = true;
    __device__ __forceinline__ bool keep(const Unit&) const { return false; }
    const bf16* HB; bf16* out;
    __device__ __forceinline__ void operator()(f32x4 (&acc)[2][2][4][2], const Unit& u, int wr, int wc, int fr, int fq) const {
        const int row0 = u.pm * 256 + wr * 64 + fr, col0 = u.pn * 256 + wc * 32 + 8 * fq;
        u32x4 hv[4][2][2];
#define EW_LOAD(hb) do { _Pragma("unroll") for (int mm = 0; mm < 2; ++mm) _Pragma("unroll") for (int bj = 0; bj < 2; ++bj) \
            hv[hb][mm][bj] = *(const u32x4*)(HB + (size_t)(row0 + ((hb) >> 1) * 128 + (2 * ((hb) & 1) + mm) * 16) * DM + col0 + bj * 128); asm volatile("" ::: "memory"); } while (0)
#define EW_COMP(hb) do { _Pragma("unroll") for (int mm = 0; mm < 2; ++mm) _Pragma("unroll") for (int bj = 0; bj < 2; ++bj) { \
            constexpr int ai = (hb) >> 1; const int m = 2 * ((hb) & 1) + mm; const u32x4 h = hv[hb][mm][bj]; bf16* op = out + (size_t)(row0 + ai * 128 + m * 16) * DM + col0 + bj * 128; \
            const f32x4 h0 = (f32x4){bf_lo(h.x), bf_hi(h.x), bf_lo(h.y), bf_hi(h.y)}, h1 = (f32x4){bf_lo(h.z), bf_hi(h.z), bf_lo(h.w), bf_hi(h.w)}; \
            const f32x4 p0 = h0 * ALPHA + acc[ai][bj][m][0], p1 = h1 * ALPHA + acc[ai][bj][m][1]; \
            u32x4 w; w.x = cvt_pk_bf16(p0[0], p0[1]); w.y = cvt_pk_bf16(p0[2], p0[3]); w.z = cvt_pk_bf16(p1[0], p1[1]); w.w = cvt_pk_bf16(p1[2], p1[3]); *(u32x4*)op = w; } asm volatile("" ::: "memory"); } while (0)
        EW_LOAD(0); EW_LOAD(1); EW_LOAD(2); EW_COMP(0); EW_LOAD(3); EW_COMP(1); EW_COMP(2); EW_COMP(3);
#undef EW_LOAD
#undef EW_COMP
    }
};
constexpr int NBK = 24;
__device__ __forceinline__ void moe_build(LAS int* mt, gu32* gcnt, int tid) {
    if (tid < NBK) mt[tid] = (int)__hip_atomic_load(gcnt + tid, RLX_AGENT);
    __syncthreads();
    if (tid == 0) { int a = 0; for (int j = 0; j < NBK; ++j) { mt[32 + j] = a; a += (mt[j] + 255) >> 8; } mt[56] = a; }
    __syncthreads();
}
__device__ __forceinline__ int mtu(const LAS int* mt, int i) { return __builtin_amdgcn_readfirstlane(mt[i]); }
__device__ __forceinline__ int moe_bucket_of(const LAS int* mt, int rt) {
    const int lane = cur_lane(); const bool p = lane < NBK && rt >= mt[33 + (lane < NBK ? lane : 0)];
    return (int)__popcll(__ballot(p));
}
template <int SH>
struct MoeOrder {
    const LAS int* mt; int G, c, ntile; const int* perm;
    __device__ __forceinline__ bool next(int i, Unit& u) const {
        const long L = (long)i * G + c; if (L >= ((long)ntile << SH)) return false;
        const int rt = (int)(L >> SH), q = (int)(L & ((1 << SH) - 1)), b = moe_bucket_of(mt, rt), g = b / 6, pi = b - 6 * g;
        const int lo = pi < 3 ? 0 : pi < 5 ? 1 : 2, hi = pi < 3 ? pi + 1 : pi < 5 ? pi - 1 : 3;
        u.pm = rt;
        if (SH == 1) { u.pn = 4 * g + (q ? hi : lo); u.pn2 = 0; u.aux = b * 2 + q; }
        else { u.pn = (4 * g + lo) * 4 + q; u.pn2 = (4 * g + hi) * 4 + q; u.aux = b * 4 + q; }
        return true;
    }
    __device__ __forceinline__ int arow(const Unit& u, int r) const {
        const int b = u.aux >> SH, slot = (u.pm - mtu(mt, 32 + b)) * 256 + r;
        return slot < mtu(mt, b) ? perm[(size_t)b * T + slot] : 0;
    }
    __device__ __forceinline__ void a_ready(const Unit&) const {}
    __device__ __forceinline__ void done(const Unit&) const {}
};
struct EpiMoeUp {
    static constexpr bool PERM = true;
    __device__ __forceinline__ bool keep(const Unit&) const { return false; }
    const LAS int* mt; const float* dwp; bf16* HID; const float* csu;
    __device__ __forceinline__ void operator()(f32x4 (&acc)[2][2][4][2], const Unit& u, int wr, int wc, int fr, int fq) const {
        const int b = u.aux >> 1, q = u.aux & 1, tb = mtu(mt, 32 + b), cnt = mtu(mt, b);
        const int r0 = wr * 64 + fr, f0 = wc * 32 + 8 * fq, col0 = q * 128 + f0;
        float dwv[2][4], rsv[2][4];
#pragma unroll
        for (int ai = 0; ai < 2; ++ai)
#pragma unroll
            for (int m = 0; m < 4; ++m) { const int slot = (u.pm - tb) * 256 + r0 + ai * 128 + m * 16; const f32x4 dv = *(const f32x4*)(dwp + ((size_t)b * T + (slot < cnt ? slot : 0)) * 4);
                dwv[ai][m] = slot < cnt ? (q ? dv.y : dv.x) : 0.f; rsv[ai][m] = slot < cnt ? dv.z : 0.f; }
        const f32x4 cg0 = *(const f32x4*)(csu + u.pn * 256 + f0), cg1 = *(const f32x4*)(csu + u.pn * 256 + f0 + 4), cu0 = *(const f32x4*)(csu + u.pn * 256 + 128 + f0), cu1 = *(const f32x4*)(csu + u.pn * 256 + 128 + f0 + 4);
#pragma unroll
        for (int ai = 0; ai < 2; ++ai)
#pragma unroll
            for (int m = 0; m < 4; ++m) { const int r = r0 + ai * 128 + m * 16; const float dw = dwv[ai][m], rs_ = rsv[ai][m];
                const i32x4 ig0 = __builtin_bit_cast(i32x4, acc[ai][0][m][0]), ig1 = __builtin_bit_cast(i32x4, acc[ai][0][m][1]), iu0 = __builtin_bit_cast(i32x4, acc[ai][1][m][0]), iu1 = __builtin_bit_cast(i32x4, acc[ai][1][m][1]);
                float h[8];
#pragma unroll
                for (int j = 0; j < 4; ++j) { const float g0 = (float)ig0[j] * (rs_ * cg0[j]), g1 = (float)ig1[j] * (rs_ * cg1[j]), u0 = (float)iu0[j] * (rs_ * cu0[j]), u1 = (float)iu1[j] * (rs_ * cu1[j]);
                    h[j] = g0 * sigmoid_fast(g0) * u0 * dw; h[4 + j] = g1 * sigmoid_fast(g1) * u1 * dw; }
                u32x4 w; w.x = cvt_pk_bf16(h[0], h[1]); w.y = cvt_pk_bf16(h[2], h[3]); w.z = cvt_pk_bf16(h[4], h[5]); w.w = cvt_pk_bf16(h[6], h[7]);
                *(u32x4*)(HID + (size_t)(u.pm * 256 + r) * 256 + col0) = w; }
    }
};
struct EpiMoeDown {
    static constexpr bool PERM = true;
    __device__ __forceinline__ bool keep(const Unit&) const { return false; }
    const LAS int* mt; const int* perm; const bf16* HB; bf16* out;
    __device__ __forceinline__ void operator()(f32x4 (&acc)[2][2][4][2], const Unit& u, int wr, int wc, int fr, int fq) const {
        const int b = u.aux >> 2, pn = u.aux & 3, tb = mtu(mt, 32 + b), cnt = mtu(mt, b);
        const int r0 = wr * 64 + fr, col0 = pn * 256 + wc * 32 + 8 * fq;
        int tok[2][4];
#pragma unroll
        for (int ai = 0; ai < 2; ++ai)
#pragma unroll
            for (int m = 0; m < 4; ++m) { const int slot = (u.pm - tb) * 256 + r0 + ai * 128 + m * 16; const int tk = perm[(size_t)b * T + (slot < cnt ? slot : 0)]; tok[ai][m] = slot < cnt ? tk : -1; }
#pragma unroll
        for (int ai = 0; ai < 2; ++ai) {
            u32x4 hv[4][2];
#pragma unroll
            for (int m = 0; m < 4; ++m) { const int tk = tok[ai][m] >= 0 ? tok[ai][m] : 0;
#pragma unroll
                for (int bj = 0; bj < 2; ++bj) hv[m][bj] = *(const u32x4*)(HB + (size_t)tk * DM + col0 + bj * 128); }
#pragma unroll
            for (int m = 0; m < 4; ++m) {
#pragma unroll
                for (int bj = 0; bj < 2; ++bj) { const u32x4 h = hv[m][bj];
                    const f32x4 h0 = (f32x4){bf_lo(h.x), bf_hi(h.x), bf_lo(h.y), bf_hi(h.y)}, h1 = (f32x4){bf_lo(h.z), bf_hi(h.z), bf_lo(h.w), bf_hi(h.w)};
                    const f32x4 p0 = h0 * ALPHA + acc[ai][bj][m][0], p1 = h1 * ALPHA + acc[ai][bj][m][1];
                    u32x4 w; w.x = cvt_pk_bf16(p0[0], p0[1]); w.y = cvt_pk_bf16(p0[2], p0[3]); w.z = cvt_pk_bf16(p1[0], p1[1]); w.w = cvt_pk_bf16(p1[2], p1[3]);
                    if (tok[ai][m] >= 0) *(u32x4*)(out + (size_t)tok[ai][m] * DM + col0 + bj * 128) = w; } }
            asm volatile("" ::: "memory"); }
    }
};
struct ProjOrder : pg8::StaticOrder {
    __device__ __forceinline__ bool next(int i, Unit& u) const { if (!pg8::StaticOrder::next(i, u)) return false; u.pn += (u.pn >= 5) ? 1 : 0; return true; }
};
struct MergeOrder {
    pg8::StaticOrder S;
    __device__ __forceinline__ bool next(int i, Unit& u) const { const int ti = i / 3, br = i - ti * 3; if (!S.next(ti, u)) return false; u.pm += br * (T / 256); u.pn += br * 4; u.pn2 = 0; u.aux = 0; return true; }
    __device__ __forceinline__ int arow(const Unit&, int) const { return 0; }
    __device__ __forceinline__ void a_ready(const Unit&) const {}
    __device__ __forceinline__ void done(const Unit&) const {}
};

struct Frame {
    LAS unsigned char* lds;
    volatile LAS unsigned* MISC;
    gu32* ctl;
    int tid, lane, wave, vcu, G, bx;
};

__device__ __forceinline__ void tr_block(const float* s, int lds_, bf16* d, int ldd, LAS float* scr, int lane) {
    f32x4 v[16];
#pragma unroll
    for (int i = 0; i < 16; ++i) v[i] = *(const f32x4*)(s + (size_t)(4 * i + (lane >> 4)) * lds_ + (lane & 15) * 4);
#pragma unroll
    for (int i = 0; i < 16; ++i) { LAS float* p = scr + (4 * i + (lane >> 4)) * 65 + (lane & 15) * 4; p[0] = v[i].x; p[1] = v[i].y; p[2] = v[i].z; p[3] = v[i].w; }
    LDS_WAIT(); asm volatile("" ::: "memory");
    const int c = lane & 7;
#pragma unroll
    for (int j = 0; j < 8; ++j) { const int n = (lane >> 3) + 8 * j; const LAS float* p = scr + (8 * c) * 65 + n;
        u32x4 o; o.x = cvt_pk_bf16(p[0 * 65], p[1 * 65]); o.y = cvt_pk_bf16(p[2 * 65], p[3 * 65]); o.z = cvt_pk_bf16(p[4 * 65], p[5 * 65]); o.w = cvt_pk_bf16(p[6 * 65], p[7 * 65]);
        *(u32x4*)(d + (size_t)n * ldd + 8 * c) = o; }
    LDS_WAIT(); asm volatile("" ::: "memory");
}
__device__ __forceinline__ void convert_strip8(const Frame& F0, const float* src, int sld, signed char* dst, float* csd) {
    Frame F = F0; F.wave = opqs(F0.wave); F.lane = cur_lane();
    LAS int* scr = (LAS int*)(F.lds + F.wave * 16896);
    LAS float* cmax = (LAS float*)(F.lds + 136192);
    const int c4 = (F.lane & 15) * 4, rg = F.lane >> 4;
    f32x4 v[2][16];
#pragma unroll
    for (int b = 0; b < 2; ++b)
#pragma unroll
        for (int i = 0; i < 16; ++i) v[b][i] = *(const f32x4*)(src + (size_t)(64 * (2 * F.wave + b) + 4 * i + rg) * sld + c4);
    f32x4 mx = (f32x4){0.f, 0.f, 0.f, 0.f};
#pragma unroll
    for (int b = 0; b < 2; ++b)
#pragma unroll
        for (int i = 0; i < 16; ++i) { mx.x = fmaxf(mx.x, fabsf(v[b][i].x)); mx.y = fmaxf(mx.y, fabsf(v[b][i].y)); mx.z = fmaxf(mx.z, fabsf(v[b][i].z)); mx.w = fmaxf(mx.w, fabsf(v[b][i].w)); }
#pragma unroll
    for (int o = 16; o < 64; o <<= 1) { mx.x = fmaxf(mx.x, shfl_xor_l(mx.x, o, F.lane)); mx.y = fmaxf(mx.y, shfl_xor_l(mx.y, o, F.lane)); mx.z = fmaxf(mx.z, shfl_xor_l(mx.z, o, F.lane)); mx.w = fmaxf(mx.w, shfl_xor_l(mx.w, o, F.lane)); }
    if (F.lane < 16) *(LAS f32x4*)(cmax + F.wave * 64 + c4) = mx;
    __syncthreads();
    f32x4 am = *(const LAS f32x4*)(cmax + c4);
#pragma unroll
    for (int w = 1; w < 8; ++w) { const f32x4 o = *(const LAS f32x4*)(cmax + w * 64 + c4); am.x = fmaxf(am.x, o.x); am.y = fmaxf(am.y, o.y); am.z = fmaxf(am.z, o.z); am.w = fmaxf(am.w, o.w); }
    am.x = fmaxf(am.x, 1e-30f); am.y = fmaxf(am.y, 1e-30f); am.z = fmaxf(am.z, 1e-30f); am.w = fmaxf(am.w, 1e-30f);
    const f32x4 inv = (f32x4){127.f / am.x, 127.f / am.y, 127.f / am.z, 127.f / am.w};
    if (F.wave == 0 && F.lane < 16) *(f32x4*)(csd + c4) = am * (1.f / 127.f);
#pragma unroll
    for (int b = 0; b < 2; ++b) {
#pragma unroll
        for (int i = 0; i < 16; ++i) { LAS int* p = scr + (4 * i + rg) * 65 + c4; p[0] = q8(v[b][i].x * inv.x); p[1] = q8(v[b][i].y * inv.y); p[2] = q8(v[b][i].z * inv.z); p[3] = q8(v[b][i].w * inv.w); }
        LDS_WAIT(); asm volatile("" ::: "memory");
        const int c8 = F.lane & 7;
#pragma unroll
        for (int j = 0; j < 8; ++j) { const int n = (F.lane >> 3) + 8 * j; const LAS int* p = scr + (8 * c8) * 65 + n;
            u32x2 o; o.x = pack4_i8(p[0 * 65], p[1 * 65], p[2 * 65], p[3 * 65]); o.y = pack4_i8(p[4 * 65], p[5 * 65], p[6 * 65], p[7 * 65]);
            *(u32x2*)(dst + (size_t)n * DM + 64 * (2 * F.wave + b) + 8 * c8) = o; }
        LDS_WAIT(); asm volatile("" ::: "memory");
    }
    __syncthreads();
}
__device__ __forceinline__ void convert_strip_item(const Frame& F, unsigned char* ws, int l, const float* w_in, const float* w_gate, const float* w_up, int s) {
    if (s < 80) convert_strip8(F, w_in + (size_t)l * DM * INC + 64 * s, INC, (signed char*)(ws + WS_WG8) + (size_t)64 * s * DM, (float*)(ws + WS_CS) + 64 * s);
    else { const int t = s - 80, e = t >> 2, up = (t >> 1) & 1, nb = t & 1;
        convert_strip8(F, (up ? w_up : w_gate) + ((size_t)l * 16 + e) * DM * 128 + 64 * nb, 128, (signed char*)(ws + WS_WU8) + (size_t)(e * 256 + up * 128 + 64 * nb) * DM, (float*)(ws + WS_CSU) + e * 256 + up * 128 + 64 * nb); }
}
__device__ __forceinline__ void convert_weights(const Frame& F0, unsigned char* ws, int l, const float* w_in, const float* w_br, const float* w_o, const float* w_gate, const float* w_up, const float* w_down, const float* sg_w, int part, int widx, int wcnt) {
    Frame F = F0; F.wave = opqs(F0.wave); F.vcu = opqs(F0.vcu); F.G = opqs(F0.G); F.lane = cur_lane(); F.tid = F.wave * 64 + F.lane;
    LAS float* scr = (LAS float*)(F.lds + F.wave * 16896);
    if (widx < 0) return;
    bf16* WIN = (bf16*)(ws + WS_WIN); bf16* WBR = (bf16*)(ws + WS_WBR); bf16* WO = (bf16*)(ws + WS_WO); bf16* WGU = (bf16*)(ws + WS_WGU); bf16* WD = (bf16*)(ws + WS_WD); bf16* SGW = (bf16*)(ws + WS_SGW);
    const float* win = w_in + (size_t)l * DM * INC; const float* wbr = w_br + (size_t)l * 3 * 256 * DM; const float* wo = w_o + (size_t)l * DM * DM;
    const float* wg = w_gate + (size_t)l * 16 * DM * 128; const float* wu = w_up + (size_t)l * 16 * DM * 128; const float* wd = w_down + (size_t)l * 16 * 128 * DM;
    constexpr int I_IN = 0, I_BR = 3 * 4 * 16, I_O = 16 * 16, I_G = 0, I_U = 0, I_D = 16 * 32;
    constexpr int NIT = I_IN + I_BR + I_O + I_G + I_U + I_D, NA = I_IN + I_BR + I_O;
    const int it0 = part == 2 ? NA : 0, it1 = part == 1 ? NA : NIT;
    for (int it = it0 + widx; it < it1; it += wcnt) {
        int r = it;
        if (r < I_IN) { const int kb = r / 32, nb = r % 32; tr_block(win + (size_t)(64 * kb) * INC + 64 * nb, INC, WIN + (size_t)(64 * nb) * DM + 64 * kb, DM, scr, F.lane); continue; } r -= I_IN;
        if (r < I_BR) { const int br = r / 64, q = r % 64, kb = q / 16, nb = q % 16; tr_block(wbr + (size_t)br * 256 * DM + (size_t)(64 * kb) * DM + 64 * nb, DM, WBR + (size_t)br * DM * 256 + (size_t)(64 * nb) * 256 + 64 * kb, 256, scr, F.lane); continue; } r -= I_BR;
        if (r < I_O) { const int kb = r / 16, nb = r % 16; tr_block(wo + (size_t)(64 * kb) * DM + 64 * nb, DM, WO + (size_t)(64 * nb) * DM + 64 * kb, DM, scr, F.lane); continue; } r -= I_O;
        if (r < I_G + I_U) { const bool up = r >= I_G; if (up) r -= I_G; const int e = r / 32, q = r % 32, kb = q / 2, nb = q % 2; const float* src = (up ? wu : wg) + (size_t)e * DM * 128;
            tr_block(src + (size_t)(64 * kb) * 128 + 64 * nb, 128, WGU + (size_t)(e >> 2) * DM * DM + (size_t)((e & 3) * 256 + (up ? 128 : 0) + 64 * nb) * DM + 64 * kb, DM, scr, F.lane); continue; } r -= I_G + I_U;
        { const int e = r / 32, q = r % 32, kb = q / 16, nb = q % 16;
          tr_block(wd + (size_t)e * 128 * DM + (size_t)(64 * kb) * DM + 64 * nb, DM, WD + (size_t)e * DM * 128 + (size_t)(64 * nb) * 128 + 64 * kb, 128, scr, F.lane); }
    }
    const float* sg = sg_w + (size_t)l * 4 * 128 * 128;
    if (part != 2) for (int i = widx * 64 + F.lane; i < 4 * 128 * 128 / 2; i += wcnt * 64) { const int e = 2 * i, t = (e >> 7) & 127, s = e & 127; const f32x2 v = *(const f32x2*)(sg + e);
        ((unsigned*)SGW)[i] = cvt_pk_bf16(s <= t ? v.x : 0.f, (s + 1) <= t ? v.y : 0.f); }
}

__device__ __forceinline__ void ln_row(const float* src, const f32x4 (&gm)[4], const f32x4 (&bt)[4], int lane, f32x4 (&y)[4]) {
    const f32x4* xr = (const f32x4*)src + lane; float s = 0.f;
#pragma unroll
    for (int j = 0; j < 4; ++j) { y[j] = xr[64 * j]; s += (y[j].x + y[j].y) + (y[j].z + y[j].w); }
    const float mean = wave_sum(s, lane) * (1.f / DM); float s2 = 0.f;
#pragma unroll
    for (int j = 0; j < 4; ++j) { y[j] = y[j] - mean; s2 += (y[j].x * y[j].x + y[j].y * y[j].y) + (y[j].z * y[j].z + y[j].w * y[j].w); }
    const float rstd = 1.f / sqrtf(wave_sum(s2, lane) * (1.f / DM) + LN_EPS);
#pragma unroll
    for (int j = 0; j < 4; ++j) y[j] = y[j] * rstd * gm[j] + bt[j];
}
__device__ __forceinline__ void store_row_q8(const f32x4 (&y)[4], unsigned char* o8, float* rsp, int lane) {
    float am = 0.f;
#pragma unroll
    for (int j = 0; j < 4; ++j) am = fmaxf(fmaxf(am, fmaxf(fabsf(y[j].x), fabsf(y[j].y))), fmaxf(fabsf(y[j].z), fabsf(y[j].w)));
    am = fmaxf(wave_max(am), 1e-20f); const float inv = 127.f / am;
#pragma unroll
    for (int j = 0; j < 4; ++j) *(unsigned*)(o8 + 256 * j + 4 * lane) = pack4_i8(q8(y[j].x * inv), q8(y[j].y * inv), q8(y[j].z * inv), q8(y[j].w * inv));
    if (lane == 0) *rsp = am * (1.f / 127.f);
}
template <bool WF32, bool WBF>
__device__ __forceinline__ void store_row(const f32x4 (&y)[4], float* of, bf16* ob, int lane) {
    f32x4* o4 = (f32x4*)of + lane; u32x2* o8 = (u32x2*)ob + lane;
#pragma unroll
    for (int j = 0; j < 4; ++j) { if (WF32) o4[64 * j] = y[j]; if (WBF) { u32x2 w; w.x = cvt_pk_bf16(y[j].x, y[j].y); w.y = cvt_pk_bf16(y[j].z, y[j].w); o8[64 * j] = w; } }
}
template <int NR>
__device__ __forceinline__ void ln_rows(const float* src, const f32x4 (&gm)[4], const f32x4 (&bt)[4], int lane, f32x4 (&y)[NR][4]) {
#pragma unroll
    for (int r = 0; r < NR; ++r) { const f32x4* xr = (const f32x4*)(src + (size_t)r * DM) + lane;
#pragma unroll
        for (int j = 0; j < 4; ++j) y[r][j] = xr[64 * j]; }
#pragma unroll
    for (int r = 0; r < NR; ++r) { float s = 0.f;
#pragma unroll
        for (int j = 0; j < 4; ++j) s += (y[r][j].x + y[r][j].y) + (y[r][j].z + y[r][j].w);
        const float mean = wave_sum(s, lane) * (1.f / DM); float s2 = 0.f;
#pragma unroll
        for (int j = 0; j < 4; ++j) { y[r][j] = y[r][j] - mean; s2 += (y[r][j].x * y[r][j].x + y[r][j].y * y[r][j].y) + (y[r][j].z * y[r][j].z + y[r][j].w * y[r][j].w); }
        const float rstd = 1.f / sqrtf(wave_sum(s2, lane) * (1.f / DM) + LN_EPS);
#pragma unroll
        for (int j = 0; j < 4; ++j) y[r][j] = y[r][j] * rstd * gm[j] + bt[j]; }
}
template <bool WF32, bool WBF>
__device__ __forceinline__ void ln_phase(const Frame& F0, const float* src, const float* gam, const float* bet, float* of, bf16* ob, unsigned char* o8, float* rs) {
    Frame F = F0; F.wave = opqs(F0.wave); F.vcu = opqs(F0.vcu); F.G = opqs(F0.G); F.lane = cur_lane(); F.tid = F.wave * 64 + F.lane;
    f32x4 gm[4], bt[4];
#pragma unroll
    for (int j = 0; j < 4; ++j) { gm[j] = ((const f32x4*)gam)[F.lane + 64 * j]; bt[j] = ((const f32x4*)bet)[F.lane + 64 * j]; }
    const int gw = F.vcu * NWAVES + F.wave, NGW = F.G * NWAVES;
    for (int m = gw * 4; m < T; m += NGW * 4) { f32x4 y[4][4]; ln_rows<4>(src + (size_t)m * DM, gm, bt, F.lane, y);
#pragma unroll
        for (int r = 0; r < 4; ++r) { store_row<WF32, WBF>(y[r], of + (size_t)(m + r) * DM, ob + (size_t)(m + r) * DM, F.lane); store_row_q8(y[r], o8 + (size_t)(m + r) * DM, rs + m + r, F.lane); } }
}

#define LNB_IDX(j, hh, lane) (512 * (j) + 8 * (lane) + 4 * (hh))
__device__ __forceinline__ void load_gb_bf(const float* gam, const float* bet, int lane, f32x4 (&gm)[4], f32x4 (&bt)[4]) {
#pragma unroll
    for (int j = 0; j < 2; ++j)
#pragma unroll
        for (int hh = 0; hh < 2; ++hh) { gm[2 * j + hh] = *(const f32x4*)(gam + LNB_IDX(j, hh, lane)); bt[2 * j + hh] = *(const f32x4*)(bet + LNB_IDX(j, hh, lane)); }
}
template <int NR>
__device__ __forceinline__ void ln_rows_bf(const bf16* src, const f32x4 (&gm)[4], const f32x4 (&bt)[4], int lane, f32x4 (&y)[NR][4]) {
    u32x4 raw[NR][2];
#pragma unroll
    for (int r = 0; r < NR; ++r)
#pragma unroll
        for (int j = 0; j < 2; ++j) raw[r][j] = *(const u32x4*)(src + (size_t)r * DM + 512 * j + 8 * lane);
#pragma unroll
    for (int r = 0; r < NR; ++r) { float s = 0.f;
#pragma unroll
        for (int j = 0; j < 2; ++j) { const u32x4 w = raw[r][j]; y[r][2 * j] = (f32x4){bf_lo(w.x), bf_hi(w.x), bf_lo(w.y), bf_hi(w.y)}; y[r][2 * j + 1] = (f32x4){bf_lo(w.z), bf_hi(w.z), bf_lo(w.w), bf_hi(w.w)}; }
#pragma unroll
        for (int j = 0; j < 4; ++j) s += (y[r][j].x + y[r][j].y) + (y[r][j].z + y[r][j].w);
        const float mean = wave_sum(s, lane) * (1.f / DM); float s2 = 0.f;
#pragma unroll
        for (int j = 0; j < 4; ++j) { y[r][j] = y[r][j] - mean; s2 += (y[r][j].x * y[r][j].x + y[r][j].y * y[r][j].y) + (y[r][j].z * y[r][j].z + y[r][j].w * y[r][j].w); }
        const float rstd = 1.f / sqrtf(wave_sum(s2, lane) * (1.f / DM) + LN_EPS);
#pragma unroll
        for (int j = 0; j < 4; ++j) y[r][j] = y[r][j] * rstd * gm[j] + bt[j]; }
}
__device__ __forceinline__ void store_row_bf_q8(const f32x4 (&y)[4], unsigned char* o8, float* rsp, int lane, LAS float* rsl = nullptr) {
    float am = 0.f;
#pragma unroll
    for (int j = 0; j < 4; ++j) am = fmaxf(fmaxf(am, fmaxf(fabsf(y[j].x), fabsf(y[j].y))), fmaxf(fabsf(y[j].z), fabsf(y[j].w)));
    am = fmaxf(wave_max(am), 1e-20f); const float inv = 127.f / am;
#pragma unroll
    for (int j = 0; j < 2; ++j) { u32x2 w; w.x = pack4_i8(q8(y[2 * j].x * inv), q8(y[2 * j].y * inv), q8(y[2 * j].z * inv), q8(y[2 * j].w * inv)); w.y = pack4_i8(q8(y[2 * j + 1].x * inv), q8(y[2 * j + 1].y * inv), q8(y[2 * j + 1].z * inv), q8(y[2 * j + 1].w * inv));
        *(u32x2*)(o8 + 512 * j + 8 * lane) = w; }
    if (lane == 0) { if (rsl) *rsl = am * (1.f / 127.f); else *rsp = am * (1.f / 127.f); }
}
template <bool WF32, bool WBF>
__device__ __forceinline__ void store_row_bf(const f32x4 (&y)[4], float* of, bf16* ob, int lane) {
#pragma unroll
    for (int j = 0; j < 2; ++j) {
        if (WF32) { *(f32x4*)(of + 512 * j + 8 * lane) = y[2 * j]; *(f32x4*)(of + 512 * j + 8 * lane + 4) = y[2 * j + 1]; }
        if (WBF) { u32x4 w; w.x = cvt_pk_bf16(y[2 * j].x, y[2 * j].y); w.y = cvt_pk_bf16(y[2 * j].z, y[2 * j].w); w.z = cvt_pk_bf16(y[2 * j + 1].x, y[2 * j + 1].y); w.w = cvt_pk_bf16(y[2 * j + 1].z, y[2 * j + 1].w);
            *(u32x4*)(ob + 512 * j + 8 * lane) = w; } }
}
template <bool WF32, bool WBF>
__device__ __forceinline__ void ln_phase_bf(const Frame& F0, const bf16* src, const float* gam, const float* bet, float* of, bf16* ob, unsigned char* o8, float* rs) {
    Frame F = F0; F.wave = opqs(F0.wave); F.vcu = opqs(F0.vcu); F.G = opqs(F0.G); F.lane = cur_lane(); F.tid = F.wave * 64 + F.lane;
    f32x4 gm[4], bt[4]; load_gb_bf(gam, bet, F.lane, gm, bt);
    const int gw = F.vcu * NWAVES + F.wave, NGW = F.G * NWAVES;
    for (int m = gw * 8; m < T; m += NGW * 8) { f32x4 y[8][4]; ln_rows_bf<8>(src + (size_t)m * DM, gm, bt, F.lane, y);
#pragma unroll
        for (int r = 0; r < 8; ++r) { store_row_bf<WF32, WBF>(y[r], of + (size_t)(m + r) * DM, ob + (size_t)(m + r) * DM, F.lane); if (WBF) store_row_bf_q8(y[r], o8 + (size_t)(m + r) * DM, rs + m + r, F.lane); } }
}

__device__ __forceinline__ void ln_router_phase(const Frame& F0, const bf16* src, bf16* hb, unsigned char* hb8, const float* gam, const float* bet, const float* w_router, const float* rbias, int* perm, float* dwp, gu32* gcnt) {
    Frame F = F0; F.wave = opqs(F0.wave); F.vcu = opqs(F0.vcu); F.G = opqs(F0.G); F.lane = cur_lane(); F.tid = F.wave * 64 + F.lane;
    constexpr int ATS = 1028;
    LAS float* AT = (LAS float*)F.lds;
    LAS float* PART = (LAS float*)(F.lds + 65792);
    LAS float* LOG = (LAS float*)(F.lds + 73984);
    LAS int* lcnt = (LAS int*)(F.lds + 90368);
    LAS int* lbase = (LAS int*)(F.lds + 90368 + 128);
    LAS int* rinfo = (LAS int*)(F.lds + 90368 + 256);
    LAS f32x4* dwl = (LAS f32x4*)(F.lds + 90368 + 2048);
    LAS float* rsl = (LAS float*)(F.lds + 90368 + 8192);
    const int RPB = T / F.G, NT = RPB / 16, row0 = F.vcu * RPB;
    if (F.tid < NBK) lcnt[F.tid] = 0;
    f32x4 gm[4], bt[4]; load_gb_bf(gam, bet, F.lane, gm, bt);
    const int mr = F.lane & 15, kq = F.lane >> 4;
    float wreg[32];
#pragma unroll
    for (int s = 0; s < 32; ++s) wreg[s] = w_router[(size_t)(128 * F.wave + 32 * kq + s) * 16 + mr];
    u32x4 raw[2][2];
#pragma unroll
    for (int r = 0; r < 2; ++r)
#pragma unroll
        for (int j = 0; j < 2; ++j) raw[r][j] = *(const u32x4*)(src + (size_t)(row0 + F.wave * 2 + r) * DM + 512 * j + 8 * F.lane);
    for (int t = 0; t < NT; ++t) {
        f32x4 y[2][4];
#pragma unroll
        for (int r = 0; r < 2; ++r) { float sm = 0.f;
#pragma unroll
            for (int j = 0; j < 2; ++j) { const u32x4 w = raw[r][j]; y[r][2 * j] = (f32x4){bf_lo(w.x), bf_hi(w.x), bf_lo(w.y), bf_hi(w.y)}; y[r][2 * j + 1] = (f32x4){bf_lo(w.z), bf_hi(w.z), bf_lo(w.w), bf_hi(w.w)}; }
#pragma unroll
            for (int j = 0; j < 4; ++j) sm += (y[r][j].x + y[r][j].y) + (y[r][j].z + y[r][j].w);
            const float mean = wave_sum(sm, F.lane) * (1.f / DM); float s2 = 0.f;
#pragma unroll
            for (int j = 0; j < 4; ++j) { y[r][j] = y[r][j] - mean; s2 += (y[r][j].x * y[r][j].x + y[r][j].y * y[r][j].y) + (y[r][j].z * y[r][j].z + y[r][j].w * y[r][j].w); }
            const float rstd = 1.f / sqrtf(wave_sum(s2, F.lane) * (1.f / DM) + LN_EPS);
#pragma unroll
            for (int j = 0; j < 4; ++j) y[r][j] = y[r][j] * rstd * gm[j] + bt[j]; }
        if (t + 1 < NT) {
#pragma unroll
            for (int r = 0; r < 2; ++r)
#pragma unroll
                for (int j = 0; j < 2; ++j) raw[r][j] = *(const u32x4*)(src + (size_t)(row0 + (t + 1) * 16 + F.wave * 2 + r) * DM + 512 * j + 8 * F.lane);
        }
#pragma unroll
        for (int r = 0; r < 2; ++r) { const int lr = F.wave * 2 + r; store_row_bf<false, true>(y[r], (float*)nullptr, hb + (size_t)(row0 + t * 16 + lr) * DM, F.lane);
            store_row_bf_q8(y[r], hb8 + (size_t)(row0 + t * 16 + lr) * DM, (float*)nullptr, F.lane, rsl + t * 16 + lr);
#pragma unroll
            for (int j = 0; j < 2; ++j) { *(LAS f32x4*)(AT + lr * ATS + 512 * j + 8 * F.lane) = y[r][2 * j]; *(LAS f32x4*)(AT + lr * ATS + 512 * j + 8 * F.lane + 4) = y[r][2 * j + 1]; } }
        __syncthreads();
        f32x4 acc = (f32x4){0.f, 0.f, 0.f, 0.f};
        { const LAS float* ap = AT + mr * ATS + 128 * F.wave + 32 * kq; f32x4 av[8];
#pragma unroll
          for (int q = 0; q < 8; ++q) av[q] = *(const LAS f32x4*)(ap + 4 * q);
#pragma unroll
          for (int q = 0; q < 8; ++q) { acc = __builtin_amdgcn_mfma_f32_16x16x4f32(av[q].x, wreg[4 * q], acc, 0, 0, 0); acc = __builtin_amdgcn_mfma_f32_16x16x4f32(av[q].y, wreg[4 * q + 1], acc, 0, 0, 0);
              acc = __builtin_amdgcn_mfma_f32_16x16x4f32(av[q].z, wreg[4 * q + 2], acc, 0, 0, 0); acc = __builtin_amdgcn_mfma_f32_16x16x4f32(av[q].w, wreg[4 * q + 3], acc, 0, 0, 0); } }
#pragma unroll
        for (int i = 0; i < 4; ++i) PART[(F.wave * 16 + 4 * kq + i) * 16 + mr] = acc[i];
        __syncthreads();
        if (F.tid < 256) { float sacc = 0.f;
#pragma unroll
            for (int w8 = 0; w8 < 8; ++w8) sacc += PART[w8 * 256 + F.tid];
            LOG[(t * 16 + (F.tid >> 4)) * 16 + (F.tid & 15)] = sacc; }
    }
    __syncthreads();
    float rb[16];
#pragma unroll
    for (int e = 0; e < 16; ++e) rb[e] = rbias[e];
    if (F.tid < RPB) {
        const int m = row0 + F.tid;
        float sc[16], sel[16];
#pragma unroll
        for (int q = 0; q < 4; ++q) { const f32x4 lg = *(const LAS f32x4*)(LOG + F.tid * 16 + 4 * q);
            sc[4 * q] = 1.f / (1.f + __expf(-lg.x)); sc[4 * q + 1] = 1.f / (1.f + __expf(-lg.y)); sc[4 * q + 2] = 1.f / (1.f + __expf(-lg.z)); sc[4 * q + 3] = 1.f / (1.f + __expf(-lg.w)); }
#pragma unroll
        for (int e = 0; e < 16; ++e) sel[e] = sc[e] + rb[e];
        float gs[4];
#pragma unroll
        for (int g = 0; g < 4; ++g) { const float a = sel[4 * g], b = sel[4 * g + 1], c = sel[4 * g + 2], d = sel[4 * g + 3];
            const float h1 = fmaxf(a, b), l1 = fminf(a, b), h2 = fmaxf(c, d), l2 = fminf(c, d); gs[g] = fmaxf(h1, h2) + fmaxf(fminf(h1, h2), fmaxf(l1, l2)); }
        int bg = 0; float bs = gs[0];
#pragma unroll
        for (int g = 1; g < 4; ++g) if (gs[g] > bs) { bs = gs[g]; bg = g; }
        float v[4], s4[4];
#pragma unroll
        for (int j = 0; j < 4; ++j) { v[j] = bg == 0 ? sel[j] : bg == 1 ? sel[4 + j] : bg == 2 ? sel[8 + j] : sel[12 + j]; s4[j] = bg == 0 ? sc[j] : bg == 1 ? sc[4 + j] : bg == 2 ? sc[8 + j] : sc[12 + j]; }
        int i1 = 0; float m1 = v[0];
#pragma unroll
        for (int j = 1; j < 4; ++j) if (v[j] > m1) { m1 = v[j]; i1 = j; }
        int i2 = -1; float m2 = -3.0e38f;
#pragma unroll
        for (int j = 0; j < 4; ++j) if (j != i1 && v[j] > m2) { m2 = v[j]; i2 = j; }
        const float s1 = i1 == 0 ? s4[0] : i1 == 1 ? s4[1] : i1 == 2 ? s4[2] : s4[3], s2 = i2 == 0 ? s4[0] : i2 == 1 ? s4[1] : i2 == 2 ? s4[2] : s4[3];
        const float inv = 1.f / (s1 + s2), w1 = s1 * inv, w2 = s2 * inv;
        const int lo = i1 < i2 ? i1 : i2, hi = i1 < i2 ? i2 : i1, bk = bg * 6 + (lo == 0 ? hi - 1 : lo == 1 ? hi + 1 : 5);
        const f32x2 dw = (f32x2){i1 < i2 ? w1 : w2, i1 < i2 ? w2 : w1};
        const int rank = atomicAdd((int*)&lcnt[bk], 1); rinfo[F.tid] = m | (bk << 16) | (rank << 21); dwl[F.tid] = (f32x4){dw.x, dw.y, rsl[F.tid], 0.f};
    }
    __syncthreads();
    if (F.tid < NBK) lbase[F.tid] = (int)__hip_atomic_fetch_add(gcnt + F.tid, (unsigned)lcnt[F.tid], RLX_AGENT);
    __syncthreads();
    if (F.tid < RPB) { const int info = rinfo[F.tid]; const int tok = info & 0xffff, bk = (info >> 16) & 31, rank = info >> 21; const size_t slot = (size_t)bk * T + lbase[bk] + rank;
        perm[slot] = tok; ((f32x4*)dwp)[slot] = dwl[F.tid]; }
    __syncthreads();
}

__device__ __forceinline__ void conv_phase(const Frame& F0, const bf16* PA, const float* cw, bf16* Y0) {
    Frame F = F0; F.wave = opqs(F0.wave); F.vcu = opqs(F0.vcu); F.G = opqs(F0.G); F.lane = cur_lane(); F.tid = F.wave * 64 + F.lane;
    for (int rr = F.vcu * NTHREADS + F.tid; rr < (T / 8) * 32; rr += F.G * NTHREADS) {
        const int co = rr & 31, run = rr >> 5, t0 = run * 8, c0 = co * 8;
        float w[3][8];
#pragma unroll
        for (int j = 0; j < 3; ++j) { const f32x4 a = *(const f32x4*)(cw + j * 256 + c0), b = *(const f32x4*)(cw + j * 256 + c0 + 4); w[j][0] = a.x; w[j][1] = a.y; w[j][2] = a.z; w[j][3] = a.w; w[j][4] = b.x; w[j][5] = b.y; w[j][6] = b.z; w[j][7] = b.w; }
        float u1[8], u2[8];
        const bool first = (t0 % SEQ) == 0;
#pragma unroll
        for (int q = 0; q < 8; ++q) { u1[q] = 0.f; u2[q] = 0.f; }
        if (!first) {
            const u32x4 h1 = *(const u32x4*)(PA + (size_t)(t0 - 1) * 768 + c0), g1 = *(const u32x4*)(PA + (size_t)(t0 - 1) * 768 + 512 + c0);
            const u32x4 h2 = *(const u32x4*)(PA + (size_t)(t0 - 2) * 768 + c0), g2 = *(const u32x4*)(PA + (size_t)(t0 - 2) * 768 + 512 + c0);
#pragma unroll
            for (int q = 0; q < 4; ++q) { u1[2 * q] = bf_lo(h1[q]) * bf_lo(g1[q]); u1[2 * q + 1] = bf_hi(h1[q]) * bf_hi(g1[q]); u2[2 * q] = bf_lo(h2[q]) * bf_lo(g2[q]); u2[2 * q + 1] = bf_hi(h2[q]) * bf_hi(g2[q]); }
        }
#pragma unroll
        for (int i = 0; i < 8; ++i) { const bf16* row = PA + (size_t)(t0 + i) * 768 + c0;
            const u32x4 hh = *(const u32x4*)row, bb = *(const u32x4*)(row + 256), cc = *(const u32x4*)(row + 512);
            float u0[8], yv[8];
#pragma unroll
            for (int q = 0; q < 4; ++q) { u0[2 * q] = bf_lo(hh[q]) * bf_lo(cc[q]); u0[2 * q + 1] = bf_hi(hh[q]) * bf_hi(cc[q]); }
#pragma unroll
            for (int q = 0; q < 8; ++q) { const float bgv = (q & 1) ? bf_hi(bb[q >> 1]) : bf_lo(bb[q >> 1]); yv[q] = bgv * (w[0][q] * u2[q] + w[1][q] * u1[q] + w[2][q] * u0[q]); u2[q] = u1[q]; u1[q] = u0[q]; }
            u32x4 o; o.x = cvt_pk_bf16(yv[0], yv[1]); o.y = cvt_pk_bf16(yv[2], yv[3]); o.z = cvt_pk_bf16(yv[4], yv[5]); o.w = cvt_pk_bf16(yv[6], yv[7]);
            *(u32x4*)(Y0 + (size_t)(t0 + i) * 256 + c0) = o; }
    }
}

__device__ __forceinline__ void attn_unit(const bf16* Q, const bf16* Kb, const bf16* VT, bf16* Y1, int b, int hd, int qt, int lane) {
    const int r = lane & 31, h = lane >> 5;
    const size_t tokb = (size_t)b * SEQ;
    bf16x8 qf[4];
    { const bf16* qp = Q + (tokb + qt * 32 + r) * 256 + hd * 64 + 8 * h;
#pragma unroll
      for (int s = 0; s < 4; ++s) qf[s] = *(const bf16x8*)(qp + 16 * s); }
    f32x16 o0, o1;
#pragma unroll
    for (int i = 0; i < 16; ++i) { o0[i] = 0.f; o1[i] = 0.f; }
    float R = 1.f;
    bf16x8 kf[4], vf[2][2], kn[4], vn[2][2];
#define AT_LOAD(KF, VF, kt_) do { const bf16* kp = Kb + (tokb + (kt_) * 32 + r) * 256 + hd * 64 + 8 * h; \
        _Pragma("unroll") for (int s = 0; s < 4; ++s) KF[s] = *(const bf16x8*)(kp + 16 * s); \
        _Pragma("unroll") for (int db = 0; db < 2; ++db) _Pragma("unroll") for (int s = 0; s < 2; ++s) { const bf16* vp = VT + (((size_t)hd * (T / 32) + (size_t)b * (SEQ / 32) + (kt_)) * 64 + db * 32 + r) * 32 + 16 * s + 4 * h; \
            const u32x2 lo = *(const u32x2*)vp, hi = *(const u32x2*)(vp + 8); const u32x4 w = (u32x4){lo.x, lo.y, hi.x, hi.y}; VF[db][s] = __builtin_bit_cast(bf16x8, w); } } while (0)
    AT_LOAD(kf, vf, qt);
    for (int kt = qt; kt >= 0; --kt) {
        { const int ktn = kt > 0 ? kt - 1 : 0; AT_LOAD(kn, vn, ktn); }
        f32x16 st;
#pragma unroll
        for (int i = 0; i < 16; ++i) st[i] = 0.f;
#pragma unroll
        for (int s = 0; s < 4; ++s) st = __builtin_amdgcn_mfma_f32_32x32x16_bf16(kf[s], qf[s], st, 0, 0, 0);
        float nb[16], bt_[16];
        const bool diag = (kt == qt);
#pragma unroll
        for (int i = 0; i < 16; ++i) { const float z = st[i]; const float e2 = __builtin_amdgcn_exp2f(-fabsf(z)); const float rr = __builtin_amdgcn_rcpf(1.f + e2), er = e2 * rr;
            const int kidx = (i & 3) + 8 * (i >> 2) + 4 * h; const bool valid = !diag || (kidx < r);
            const float b1 = z >= 0.f ? rr : er, n1 = z >= 0.f ? er : rr;
            nb[i] = valid ? n1 : 1.f; bt_[i] = valid ? b1 : 0.f; }
        float Gs[4], Go[4];
#pragma unroll
        for (int g = 0; g < 4; ++g) { Gs[g] = (nb[4 * g] * nb[4 * g + 1]) * (nb[4 * g + 2] * nb[4 * g + 3]); Go[g] = shfl_xor_l(Gs[g], 32, lane); }
        float tail[4]; tail[3] = 1.f; tail[2] = Gs[3] * Go[3]; tail[1] = tail[2] * (Gs[2] * Go[2]); tail[0] = tail[1] * (Gs[1] * Go[1]);
        const float total = tail[0] * (Gs[0] * Go[0]);
        float p[16];
#pragma unroll
        for (int g = 0; g < 4; ++g) { const float base = R * tail[g] * (h == 0 ? Go[g] : 1.f);
            const float w3 = base, w2 = w3 * nb[4 * g + 3], w1 = w2 * nb[4 * g + 2], w0 = w1 * nb[4 * g + 1];
            p[4 * g + 3] = bt_[4 * g + 3] * w3; p[4 * g + 2] = bt_[4 * g + 2] * w2; p[4 * g + 1] = bt_[4 * g + 1] * w1; p[4 * g] = bt_[4 * g] * w0; }
        R *= total;
        bf16x8 pf[2];
#pragma unroll
        for (int s = 0; s < 2; ++s) { u32x4 w; w.x = cvt_pk_bf16(p[8 * s], p[8 * s + 1]); w.y = cvt_pk_bf16(p[8 * s + 2], p[8 * s + 3]); w.z = cvt_pk_bf16(p[8 * s + 4], p[8 * s + 5]); w.w = cvt_pk_bf16(p[8 * s + 6], p[8 * s + 7]); pf[s] = __builtin_bit_cast(bf16x8, w); }
#pragma unroll
        for (int s = 0; s < 2; ++s) { o0 = __builtin_amdgcn_mfma_f32_32x32x16_bf16(vf[0][s], pf[s], o0, 0, 0, 0); o1 = __builtin_amdgcn_mfma_f32_32x32x16_bf16(vf[1][s], pf[s], o1, 0, 0, 0); }
        if (__all(R < 1.2664e-14f)) break;
#pragma unroll
        for (int s = 0; s < 4; ++s) kf[s] = kn[s];
#pragma unroll
        for (int db = 0; db < 2; ++db)
#pragma unroll
            for (int s = 0; s < 2; ++s) vf[db][s] = vn[db][s];
    }
#undef AT_LOAD
    bf16* yp = Y1 + (tokb + qt * 32 + r) * 256 + hd * 64 + 4 * h;
#pragma unroll
    for (int g = 0; g < 4; ++g) { u32x2 w; w.x = cvt_pk_bf16(o0[4 * g], o0[4 * g + 1]); w.y = cvt_pk_bf16(o0[4 * g + 2], o0[4 * g + 3]); *(u32x2*)(yp + 8 * g) = w;
        u32x2 w1; w1.x = cvt_pk_bf16(o1[4 * g], o1[4 * g + 1]); w1.y = cvt_pk_bf16(o1[4 * g + 2], o1[4 * g + 3]); *(u32x2*)(yp + 32 + 8 * g) = w1; }
}
__device__ __forceinline__ void attn_phase(const Frame& F0, const bf16* Q, const bf16* Kb, const bf16* VT, bf16* Y1) {
    Frame F = F0; F.wave = opqs(F0.wave); F.vcu = opqs(F0.vcu); F.G = opqs(F0.G); F.lane = cur_lane(); F.tid = F.wave * 64 + F.lane;
    const int gw = F.vcu * NWAVES + F.wave, NGW = F.G * NWAVES;
    for (int u = gw; u < (T / 32) * 4; u += NGW) { const int hd = u >> 10, tt = u & 1023, b = tt >> 9, qt = tt & 511; attn_unit(Q, Kb, VT, Y1, b, hd, qt, F.lane); }
}

constexpr int VTP = 136;
__device__ __forceinline__ void gmlp_phase(const Frame& F0, const bf16* UC, const bf16* SGW, const float* sgb, const float* lng, const float* lnb, bf16* Y2) {
    Frame F = F0; F.wave = opqs(F0.wave); F.vcu = opqs(F0.vcu); F.G = opqs(F0.G); F.lane = cur_lane(); F.tid = F.wave * 64 + F.lane;
    LAS bf16* VTl = (LAS bf16*)F.lds;
    const int lane = F.lane, w = F.wave, r = lane & 31, h = lane >> 5;
    const f32x4 g4 = ((const f32x4*)lng)[lane], b4 = ((const f32x4*)lnb)[lane];
    for (int ch = F.vcu; ch < T / 128; ch += F.G) {
        const size_t tok0 = (size_t)ch * 128;
        bf16x8 wfr[8][2];
        { const int g_ = w >> 1, th_ = w & 1;
#pragma unroll
          for (int ks = 0; ks < 8; ++ks)
#pragma unroll
              for (int tb = 0; tb < 2; ++tb) wfr[ks][tb] = *(const bf16x8*)(SGW + ((size_t)g_ * 128 + 64 * th_ + 32 * tb + r) * 128 + 16 * ks + 8 * h); }
        u32x2 raw[16];
#pragma unroll
        for (int i = 0; i < 16; ++i) raw[i] = *(const u32x2*)(UC + (tok0 + w * 16 + i) * 512 + 256 + 4 * lane);
#pragma unroll
        for (int ip = 0; ip < 8; ++ip) { unsigned pk[2][2];
#pragma unroll
            for (int q = 0; q < 2; ++q) { const u32x2 rw = raw[2 * ip + q];
                float x0 = bf_lo(rw.x), x1 = bf_hi(rw.x), x2 = bf_lo(rw.y), x3 = bf_hi(rw.y);
                const float mean = wave_sum((x0 + x1) + (x2 + x3), lane) * (1.f / 256.f); x0 -= mean; x1 -= mean; x2 -= mean; x3 -= mean;
                const float rstd = 1.f / sqrtf(wave_sum((x0 * x0 + x1 * x1) + (x2 * x2 + x3 * x3), lane) * (1.f / 256.f) + LN_EPS);
                pk[q][0] = cvt_pk_bf16(x0 * rstd * g4.x + b4.x, x1 * rstd * g4.y + b4.y); pk[q][1] = cvt_pk_bf16(x2 * rstd * g4.z + b4.z, x3 * rstd * g4.w + b4.w); }
            const int s0 = w * 16 + 2 * ip;
            LAS unsigned* vt32 = (LAS unsigned*)VTl;
            vt32[((4 * lane + 0) * VTP + s0) >> 1] = (pk[0][0] & 0xffffu) | (pk[1][0] << 16); vt32[((4 * lane + 1) * VTP + s0) >> 1] = (pk[0][0] >> 16) | (pk[1][0] & 0xffff0000u);
            vt32[((4 * lane + 2) * VTP + s0) >> 1] = (pk[0][1] & 0xffffu) | (pk[1][1] << 16); vt32[((4 * lane + 3) * VTP + s0) >> 1] = (pk[0][1] >> 16) | (pk[1][1] & 0xffff0000u); }
        __syncthreads();
        const int g = w >> 1, th = w & 1;
        f32x16 acc[2][2];
#pragma unroll
        for (int a = 0; a < 2; ++a)
#pragma unroll
            for (int b = 0; b < 2; ++b)
#pragma unroll
                for (int i = 0; i < 16; ++i) acc[a][b][i] = 0.f;
#pragma unroll
        for (int ks = 0; ks < 8; ++ks) {
            bf16x8 af[2];
#pragma unroll
            for (int cb = 0; cb < 2; ++cb) af[cb] = *(const LAS bf16x8*)(VTl + (g * 64 + cb * 32 + r) * VTP + 16 * ks + 8 * h);
#pragma unroll
            for (int cb = 0; cb < 2; ++cb)
#pragma unroll
                for (int tb = 0; tb < 2; ++tb) acc[cb][tb] = __builtin_amdgcn_mfma_f32_32x32x16_bf16(af[cb], wfr[ks][tb], acc[cb][tb], 0, 0, 0);
        }
#pragma unroll
        for (int tb = 0; tb < 2; ++tb) { const int t = 64 * th + 32 * tb + r; const float bias = sgb[g * 128 + t]; const size_t tok = tok0 + t;
#pragma unroll
            for (int cb = 0; cb < 2; ++cb)
#pragma unroll
                for (int q = 0; q < 4; ++q) { const int c0 = g * 64 + cb * 32 + 8 * q + 4 * h; const u32x2 uu = *(const u32x2*)(UC + tok * 512 + c0);
                    u32x2 o; o.x = cvt_pk_bf16(bf_lo(uu.x) * (acc[cb][tb][4 * q] + bias), bf_hi(uu.x) * (acc[cb][tb][4 * q + 1] + bias));
                    o.y = cvt_pk_bf16(bf_lo(uu.y) * (acc[cb][tb][4 * q + 2] + bias), bf_hi(uu.y) * (acc[cb][tb][4 * q + 3] + bias));
                    *(u32x2*)(Y2 + tok * 256 + c0) = o; } }
        __syncthreads();
    }
}

template <class Tp> __device__ __forceinline__ Tp* karg(int idx) {
    int off = 8 * idx; asm volatile("" : "+s"(off));
    const __attribute__((address_space(4))) char* kp = (const __attribute__((address_space(4))) char*)__builtin_amdgcn_kernarg_segment_ptr();
    const unsigned long long v = *(const __attribute__((address_space(4))) unsigned long long*)(kp + off);
    return (Tp*)(GAS Tp*)v;
}
#define KIN(i) karg<const float>(i)
#define KOUT() karg<float>(21)
#define KWS() karg<unsigned char>(22)
struct Args { const float* in[21]; float* out; unsigned char* ws; int ph_lo, ph_hi; };
__global__ void __launch_bounds__(NTHREADS, 2) fwd(Args args) {
    extern __shared__ __attribute__((aligned(16))) unsigned char lds[];
    Frame F;
    F.lds = (LAS unsigned char*)lds;
    F.MISC = (volatile LAS unsigned*)(F.lds + MISC_OFF);
    F.wave = __builtin_amdgcn_readfirstlane((int)threadIdx.x >> 6); F.lane = 0; F.tid = 0;
    F.G = gridDim.x; F.bx = blockIdx.x; { const int bx = blockIdx.x; F.vcu = (F.G % 8 == 0) ? (bx % 8) * (F.G / 8) + bx / 8 : bx; }
    F.ctl = (gu32*)(KWS() + WS_CTL);
    for (int u = threadIdx.x; u < (LDS_BYTES - LDSCTL_OFF) / 4; u += NTHREADS) ((LAS unsigned*)(F.lds + LDSCTL_OFF))[u] = 0u;
    __syncthreads();
    for (int i = threadIdx.x; i < SIGT_N; i += NTHREADS) { const float x = -8.f + ((float)i + 0.5f) * (1.f / 128.f); ((LAS unsigned char*)(F.lds + SIGT_OFF))[i] = (unsigned char)(255.f / (1.f + __expf(-x)) + 0.5f); }
    __syncthreads();
    XcdBarrier bar = xcd_barrier_post((unsigned*)(F.ctl + CW_BAR), F.MISC + 8);
    const int lo = args.ph_lo, hi = args.ph_hi;
#define IN(k) (lo <= (k) && (k) < hi)
#define SEAM(k) do { if (IN(k) && IN((k) + 1)) for (int rb_ = 0; rb_ < REP_BAR; ++rb_) { XcdBarrier b2; b2.bar = (unsigned*)((gu32*)(KWS() + WS_CTL) + CW_BAR); b2.x = (unsigned)opqs((int)bar.x); b2.st = F.MISC + 8; xcd_barrier(b2, opqs(F.wave) == 0 && cur_lane() == 0); } } while (0)

    if (IN(0)) {
        for (int rep = 0; rep < REP_P0; ++rep) {
        for (int s_ = opqs(F.vcu); s_ < 144; s_ += opqs(F.G)) convert_strip_item(F, KWS(), 0, KIN(3), KIN(16), KIN(17), s_);
        convert_weights(F, KWS(), 0, KIN(3), KIN(10), KIN(11), KIN(16), KIN(17), KIN(18), KIN(6), 0, opqs(F.vcu) * NWAVES + opqs(F.wave), opqs(F.G) * NWAVES);
        ln_phase<false, true>(F, KIN(0), KIN(1), KIN(2), KOUT(), (bf16*)(KWS() + WS_HB), KWS() + WS_HB8, (float*)(KWS() + WS_RS)); }
        SEAM(0);
    }
    for (int l = 0; l < DEPTH; ++l) {
        const int p0 = 1 + 8 * l;
        if (IN(p0)) {
            { unsigned char* ws = KWS(); pg8::Gemm g{(bf16*)(ws + WS_HB8), (bf16*)(ws + WS_WG8), T, 7 * 256, DM / 2, 0}; ProjOrder S; S.init(T, 7 * 256, opqs(F.G), opqs(F.bx));
              EpiProj E{(bf16*)(ws + WS_PA), (bf16*)(ws + WS_Q), (bf16*)(ws + WS_K), (bf16*)(ws + WS_UC), (unsigned char*)(ws + WS_GATE), KIN(4) + (size_t)l * 3 * DM, (const LAS unsigned char*)(F.lds + SIGT_OFF), (const float*)(ws + WS_RS), (const float*)(ws + WS_CS)};
              pg8::gemm_phase<EpiProj, ProjOrder, true, false, false, true>(F.lds, opqs(F.wave), g, S, E); }
            { unsigned char* ws = KWS(); pg8::Gemm g{(bf16*)(ws + WS_WG8 + (size_t)1280 * DM), (bf16*)(ws + WS_HB8), 256, T, DM / 2, 0}; pg8::StaticOrder S; { const int G_ = opqs(F.G); S.init(256, T, G_, (opqs(F.bx) + G_ / 2) % G_); }
              EpiVt E{(bf16*)(ws + WS_VT), (const float*)(ws + WS_RS), (const float*)(ws + WS_CS)};
              pg8::gemm_phase<EpiVt, pg8::StaticOrder, true, false, false, true>(F.lds, opqs(F.wave), g, S, E); }
            { unsigned char* ws = KWS(); pg8::Gemm g{(bf16*)(ws + WS_HB8), (bf16*)(ws + WS_WG8 + (size_t)2048 * DM), T, 12 * 256, DM / 2, 0}; pg8::StaticOrder S; S.init(T, 12 * 256, opqs(F.G), opqs(F.bx));
              EpiGate E{(unsigned char*)(ws + WS_GATE), KIN(4) + (size_t)l * 3 * DM, (const float*)(ws + WS_RS), (const float*)(ws + WS_CS) + 2048, (const LAS unsigned char*)(F.lds + SIGT_OFF)};
              pg8::gemm_phase<EpiGate, pg8::StaticOrder, true, false, false, true>(F.lds, opqs(F.wave), g, S, E); }
            SEAM(p0);
        }
        if (IN(p0 + 1)) {
            for (int rep = 0; rep < REP_P2; ++rep) {
            if (l > 0) { convert_weights(F, KWS(), l, KIN(3), KIN(10), KIN(11), KIN(16), KIN(17), KIN(18), KIN(6), 2, opqs(F.vcu) * NWAVES + opqs(F.wave), opqs(F.G) * NWAVES); __syncthreads(); }
            for (int ra = 0; ra < REP_P2A; ++ra) { unsigned char* ws = KWS(); attn_phase(F, (bf16*)(ws + WS_Q), (bf16*)(ws + WS_K), (bf16*)(ws + WS_VT), (bf16*)(ws + WS_Y) + (size_t)T * 256); }
            for (int rb = 0; rb < REP_P2B; ++rb) { unsigned char* ws = KWS(); gmlp_phase(F, (bf16*)(ws + WS_UC), (bf16*)(ws + WS_SGW), KIN(7) + (size_t)l * 512, KIN(8) + (size_t)l * 256, KIN(9) + (size_t)l * 256, (bf16*)(ws + WS_Y) + (size_t)2 * T * 256); }
            for (int rc = 0; rc < REP_P2C; ++rc) { unsigned char* ws = KWS(); conv_phase(F, (bf16*)(ws + WS_PA), KIN(5) + (size_t)l * 768, (bf16*)(ws + WS_Y)); }
            }
            SEAM(p0 + 1);
        }
        if (IN(p0 + 2)) {
            for (int rep = 0; rep < REP_P3; ++rep) {
            unsigned char* ws = KWS(); pg8::Gemm g{(bf16*)(ws + WS_Y), (bf16*)(ws + WS_WBR), 3 * T, 3 * DM, 256}; MergeOrder S; S.S.init(T, DM, opqs(F.G), opqs(F.bx));
            EpiMerge E{(const unsigned char*)(ws + WS_GATE), (bf16*)(ws + WS_MG)};
            pg8::gemm_phase<EpiMerge, MergeOrder, true, false>(F.lds, opqs(F.wave), g, S, E); }
            SEAM(p0 + 2);
        }
        if (IN(p0 + 3)) {
            for (int rep = 0; rep < REP_P4; ++rep) {
            unsigned char* ws = KWS(); pg8::Gemm g{(bf16*)(ws + WS_MG), (bf16*)(ws + WS_WO), T, DM, DM}; pg8::StaticOrder S; S.init(T, DM, opqs(F.G), opqs(F.bx));
            EpiWo E{(bf16*)(ws + WS_HB), (bf16*)(ws + (rep + 1 < REP_P4 ? WS_PRE + 64 * MiB : WS_PRE))};
            pg8::gemm_phase<EpiWo, pg8::StaticOrder, true, false>(F.lds, opqs(F.wave), g, S, E); }
            SEAM(p0 + 3);
        }
        if (IN(p0 + 4)) {
            { unsigned char* ws = KWS();
            ln_router_phase(F, (bf16*)(ws + WS_PRE), (bf16*)(ws + WS_HB), ws + WS_HB8, KIN(12) + (size_t)l * DM, KIN(13) + (size_t)l * DM, KIN(14), KIN(15), (int*)(ws + WS_PERM), (float*)(ws + WS_DWP), (gu32*)(ws + WS_CTL) + CW_CNT + 64 * l); }
            SEAM(p0 + 4);
        }
        if (IN(p0 + 5)) {
            for (int rep = 0; rep < REP_P6; ++rep) {
            unsigned char* ws = KWS(); LAS int* mt = (LAS int*)(F.lds + MOE_OFF); moe_build(mt, (gu32*)(ws + WS_CTL) + CW_CNT + 64 * l, opqs(F.wave) * 64 + cur_lane());
            pg8::Gemm g{(bf16*)(ws + WS_HB8), (bf16*)(ws + WS_WU8), T, 4 * DM, DM / 2, 0}; MoeOrder<1> S{mt, opqs(F.G), opqs(F.bx), mtu(mt, 56), (int*)(ws + WS_PERM)};
            EpiMoeUp E{mt, (float*)(ws + WS_DWP), (bf16*)(ws + WS_PA), (const float*)(ws + WS_CSU)};
            pg8::gemm_phase<EpiMoeUp, MoeOrder<1>, true, true, false, true>(F.lds, opqs(F.wave), g, S, E);
            if (l + 1 < DEPTH && rep + 1 == REP_P6) {
                const int G_ = opqs(F.G), nfull = mtu(mt, 56) * 2 > G_ ? (mtu(mt, 56) * 2 - G_ < G_ ? mtu(mt, 56) * 2 - G_ : G_ - 1) : 0, c_ = opqs(F.bx);
                if (c_ >= nfull) for (int s_ = c_ - nfull; s_ < 80; s_ += G_ - nfull) convert_strip_item(F, KWS(), l + 1, KIN(3), KIN(16), KIN(17), s_);
                convert_weights(F, KWS(), l + 1, KIN(3), KIN(10), KIN(11), KIN(16), KIN(17), KIN(18), KIN(6), 1, c_ >= nfull ? (c_ - nfull) * NWAVES + opqs(F.wave) : -1, (G_ - nfull) * NWAVES); } }
            SEAM(p0 + 5);
        }
        if (IN(p0 + 6)) {
            for (int rep = 0; rep < REP_P7; ++rep) {
            unsigned char* ws = KWS(); LAS int* mt = (LAS int*)(F.lds + MOE_OFF); moe_build(mt, (gu32*)(ws + WS_CTL) + CW_CNT + 64 * l, opqs(F.wave) * 64 + cur_lane());
            pg8::Gemm g{(bf16*)(ws + WS_PA), (bf16*)(ws + WS_WD), T + NBK * 256, 4 * DM, 256, 128}; MoeOrder<2> S{mt, opqs(F.G), opqs(F.bx), mtu(mt, 56), (int*)(ws + WS_PERM)};
            EpiMoeDown E{mt, (int*)(ws + WS_PERM), (bf16*)(ws + WS_HB), (bf16*)(ws + (rep + 1 < REP_P7 ? WS_PRE + 64 * MiB : WS_PRE))};
            pg8::gemm_phase<EpiMoeDown, MoeOrder<2>, true, false, true>(F.lds, opqs(F.wave), g, S, E);
            if (l + 1 < DEPTH && rep + 1 == REP_P7) {
                const int G_ = opqs(F.G), nu_ = mtu(mt, 56) * 4, n3_ = nu_ > 2 * G_ ? (nu_ - 2 * G_ < G_ ? nu_ - 2 * G_ : G_ - 1) : 0, c_ = opqs(F.bx);
                if (c_ >= n3_) for (int s_ = 80 + c_ - n3_; s_ < 144; s_ += G_ - n3_) convert_strip_item(F, KWS(), l + 1, KIN(3), KIN(16), KIN(17), s_); } }
            SEAM(p0 + 6);
        }
        if (IN(p0 + 7)) {
            for (int rep = 0; rep < REP_P8; ++rep) { const bool dry = rep + 1 < REP_P8;
            { float* out = KOUT(); unsigned char* ws = KWS(); float* of = dry ? (float*)(ws + WS_PRE + 64 * MiB) : out; bf16* ob = (bf16*)(ws + (dry ? WS_PRE + 64 * MiB : WS_HB)); const bf16* pre = (const bf16*)(ws + WS_PRE);
              if (l + 1 < DEPTH) ln_phase_bf<false, true>(F, pre, KIN(19) + (size_t)l * DM, KIN(20) + (size_t)l * DM, of, ob, ws + WS_HB8, (float*)(ws + WS_RS)); else ln_phase_bf<true, false>(F, pre, KIN(19) + (size_t)l * DM, KIN(20) + (size_t)l * DM, of, ob, ws + WS_HB8, (float*)(ws + WS_RS)); } }
            SEAM(p0 + 7);
        }
    }
#undef IN
#undef SEAM
}

extern "C" void kernel_launch(void* const* d_in, const int* in_sizes, int n_in, void* d_out, int out_size, void* d_ws, size_t ws_size, hipStream_t stream) {
    static int grid = 0;
    if (grid == 0) {
        if (n_in != 21 || out_size != T * DM || ws_size < WS_END) { fprintf(stderr, "kernel_launch: unexpected shapes (n_in %d out %d ws %zu)\n", n_in, out_size, ws_size); grid = -1; return; }
        int dev = 0, cus = 0, per_cu = 0;
        if (hipGetDevice(&dev) != hipSuccess || hipDeviceGetAttribute(&cus, hipDeviceAttributeMultiprocessorCount, dev) != hipSuccess) { grid = -1; return; }
        if (hipFuncSetAttribute((const void*)fwd, hipFuncAttributeMaxDynamicSharedMemorySize, LDS_BYTES) != hipSuccess) { fprintf(stderr, "kernel_launch: hipFuncSetAttribute failed\n"); grid = -1; return; }
        if (hipOccupancyMaxActiveBlocksPerMultiprocessor(&per_cu, (const void*)fwd, NTHREADS, LDS_BYTES) != hipSuccess || per_cu < 1) fprintf(stderr, "kernel_launch: occupancy query says %d\n", per_cu);
        (void)hipGetLastError();
        if (cus < 256) { fprintf(stderr, "kernel_launch: this kernel is laid out for 256 resident workgroups (one per CU); the device reports %d CUs\n", cus); grid = -1; return; }
        grid = 256;
    }
    if (grid < 0) return;
    (void)hipMemsetAsync((char*)d_ws + WS_CTL, 0, CTL_ZERO_BYTES, stream);
    Args a{};
    for (int i = 0; i < 21; ++i) a.in[i] = (const float*)d_in[i];
    a.out = (float*)d_out; a.ws = (unsigned char*)d_ws;
#if MK_PER_PHASE
    for (int p = 0; p < NPH; ++p) { a.ph_lo = p; a.ph_hi = p + 1; hipLaunchKernelGGL(fwd, dim3(grid), dim3(NTHREADS), LDS_BYTES, stream, a); }
#else
    a.ph_lo = 0; a.ph_hi = NPH;
    hipLaunchKernelGGL(fwd, dim3(grid), dim3(NTHREADS), LDS_BYTES, stream, a);
#endif
}
```

```cpp
#include <hip/hip_runtime.h>
#include <cstdio>
#include <cstdint>

#ifndef MK_PER_PHASE
#define MK_PER_PHASE 0
#endif

#ifndef REP_P0
#define REP_P0 1
#define REP_P1 1
#define REP_P2 1
#define REP_P3 1
#define REP_P4 1
#define REP_P5 1
#define REP_P6 1
#define REP_P7 1
#define REP_P8 1
#define REP_BAR 1
#define REP_P2A 1
#define REP_P2B 1
#define REP_P2C 1
#endif
#define GAS __attribute__((address_space(1)))
#define LAS __attribute__((address_space(3)))
typedef unsigned short bf16;
typedef short bf16x8 __attribute__((ext_vector_type(8)));
typedef float f32x4 __attribute__((ext_vector_type(4)));
typedef float f32x2 __attribute__((ext_vector_type(2)));
typedef float f32x16 __attribute__((ext_vector_type(16)));
typedef unsigned u32x4 __attribute__((ext_vector_type(4)));
typedef unsigned u32x2 __attribute__((ext_vector_type(2)));
typedef GAS unsigned gu32;

constexpr int DM = 1024, BATCH = 2, SEQ = 16384, T = BATCH * SEQ, DEPTH = 4, INC = 5120;
constexpr float ALPHA = 1.6817928305074292f;
constexpr float LN_EPS = 1e-5f;
constexpr int NWAVES = 8, NTHREADS = 512;
constexpr int NPH = 1 + 8 * DEPTH;

constexpr size_t MiB = 1u << 20;
constexpr size_t WS_CTL = 0, CTL_ZERO_BYTES = 1 * MiB;
constexpr size_t WS_WIN = 1 * MiB;
constexpr size_t WS_WBR = 11 * MiB;
constexpr size_t WS_WO = 13 * MiB;
constexpr size_t WS_WGU = 15 * MiB;
constexpr size_t WS_WD = 23 * MiB;
constexpr size_t WS_SGW = 27 * MiB;
constexpr size_t WS_PERM = 416 * MiB;
constexpr size_t WS_DWP = 420 * MiB;
constexpr size_t WS_HB = 32 * MiB;
constexpr size_t WS_PA = 96 * MiB;
constexpr size_t WS_Q = 144 * MiB;
constexpr size_t WS_MG = 144 * MiB;
constexpr size_t WS_K = 160 * MiB;
constexpr size_t WS_VT = 176 * MiB;
constexpr size_t WS_UC = 192 * MiB;
constexpr size_t WS_GATE = 224 * MiB;
constexpr size_t WS_PRE = 224 * MiB;
constexpr size_t WS_Y = 416 * MiB;
constexpr size_t WS_HB8 = 464 * MiB;
constexpr size_t WS_RS = 496 * MiB;
constexpr size_t WS_WG8 = 497 * MiB;
constexpr size_t WS_CS = 502 * MiB;
constexpr size_t WS_WU8 = 503 * MiB;
constexpr size_t WS_CSU = 507 * MiB;
constexpr size_t WS_END = 508 * MiB;

constexpr int CW_TMO = 0, CW_CODE = 1, CW_BAR = 4096, CW_CNT = 8192;

constexpr int RING_BYTES = 131072, ROWTAB_OFF = RING_BYTES, ROWTAB_BYTES = 8192, LDSCTL_OFF = ROWTAB_OFF + ROWTAB_BYTES, MISC_OFF = LDSCTL_OFF + 320, MOE_OFF = MISC_OFF + 192, SIGT_OFF = MOE_OFF + 256;
constexpr int SIGT_N = 2048;
constexpr int LDS_BYTES = 147456;

__device__ __forceinline__ unsigned cvt_pk_bf16(float lo, float hi) { unsigned r; asm volatile("v_cvt_pk_bf16_f32 %0, %1, %2" : "=v"(r) : "v"(lo), "v"(hi)); return r; }
__device__ __forceinline__ float bf_lo(unsigned u) { return __uint_as_float(u << 16); }
__device__ __forceinline__ float bf_hi(unsigned u) { return __uint_as_float(u & 0xffff0000u); }
__device__ __forceinline__ float shfl_xor_l(float v, int mask, int lane) { return __int_as_float(__builtin_amdgcn_ds_bpermute((lane ^ mask) << 2, __float_as_int(v))); }
typedef int i32x4 __attribute__((ext_vector_type(4)));
__device__ __forceinline__ int q8(float x) { return (int)__builtin_rintf(__builtin_amdgcn_fmed3f(x, -127.f, 127.f)); }
__device__ __forceinline__ unsigned pack4_i8(int a, int b, int c, int d) { return (unsigned)(a & 0xff) | ((unsigned)(b & 0xff) << 8) | ((unsigned)(c & 0xff) << 16) | ((unsigned)d << 24); }
template <int CTRL> __device__ __forceinline__ float dpp_f(float v) { return __int_as_float(__builtin_amdgcn_update_dpp(0, __float_as_int(v), CTRL, 0xf, 0xf, true)); }
__device__ __forceinline__ float wave_sum(float v, int lane) {
    (void)lane;
    v += dpp_f<0xB1>(v);
    v += dpp_f<0x4E>(v);
    v += dpp_f<0x141>(v);
    v += dpp_f<0x140>(v);
    const int iv = __float_as_int(v);
    const float a = __int_as_float(__builtin_amdgcn_readlane(iv, 0)), b = __int_as_float(__builtin_amdgcn_readlane(iv, 16)), c = __int_as_float(__builtin_amdgcn_readlane(iv, 32)), d = __int_as_float(__builtin_amdgcn_readlane(iv, 48));
    return (a + b) + (c + d);
}
__device__ __forceinline__ float sigmoid_fast(float x) { return __builtin_amdgcn_rcpf(1.f + __builtin_amdgcn_exp2f(-1.4426950409f * x)); }
__device__ __forceinline__ float gelu_tanh(float x) { const float u = x * (1.f + 0.044715f * x * x); return x * __builtin_amdgcn_rcpf(1.f + __builtin_amdgcn_exp2f(-2.302208198f * u)); }
#define LDS_WAIT() asm volatile("s_waitcnt lgkmcnt(0)" ::: "memory")
#define VM_WAIT() asm volatile("s_waitcnt vmcnt(0)" ::: "memory")
#define RLX_AGENT __ATOMIC_RELAXED, __HIP_MEMORY_SCOPE_AGENT

__device__ __forceinline__ int opq(int v) { asm volatile("" : "+v"(v)); return v; }
__device__ __forceinline__ int opqs(int v) { asm volatile("" : "+s"(v)); return v; }
__device__ __forceinline__ int cur_lane() { int l; asm volatile("v_mbcnt_lo_u32_b32 %0, -1, 0\n\tv_mbcnt_hi_u32_b32 %0, -1, %0" : "=v"(l)); return l; }
__device__ __forceinline__ void glds16(const void* gsrc, unsigned lds_dst) { unsigned keep;
    asm volatile("s_mov_b32 %0, m0\n\ts_mov_b32 m0, %2\n\ts_nop 0\n\tglobal_load_lds_dwordx4 %1, off\n\ts_mov_b32 m0, %0" : "=&s"(keep) : "v"(gsrc), "s"(lds_dst) : "memory"); }
__device__ __forceinline__ float wave_max(float v) {
    v = fmaxf(v, dpp_f<0xB1>(v)); v = fmaxf(v, dpp_f<0x4E>(v)); v = fmaxf(v, dpp_f<0x141>(v)); v = fmaxf(v, dpp_f<0x140>(v));
    const int iv = __float_as_int(v);
    return fmaxf(fmaxf(__int_as_float(__builtin_amdgcn_readlane(iv, 0)), __int_as_float(__builtin_amdgcn_readlane(iv, 16))), fmaxf(__int_as_float(__builtin_amdgcn_readlane(iv, 32)), __int_as_float(__builtin_amdgcn_readlane(iv, 48))));
}
namespace pg8 {
#define PG8_LAS __attribute__((address_space(3)))
typedef unsigned short bf16_t;
constexpr int BM = 256, BK = 64, HALF = 128, HTB = HALF * BK * 2, STAGE_BYTES = 8 * HTB, NXCD = 8, WGM = 8, MAXU = 8;

__host__ __device__ __forceinline__ int lds_byte(int r, int c) { const int st = (r >> 4) * 2 + (c >> 5), rr = r & 15, cc = c & 31, ob = rr * 64 + cc * 2; return st * 1024 + (ob ^ (((ob >> 9) & 1) << 5)); }
__host__ __device__ __forceinline__ void stage_rc(int b, int& R, int& C) { const int st = b / 1024, sb = b % 1024, swz = sb ^ (((sb >> 9) & 1) << 5); R = (st >> 1) * 16 + swz / 64; C = (st & 1) * 32 + (swz % 64) / 2; }
__host__ __device__ __forceinline__ int perm32(int rho) { const int n = rho >> 4, i = rho & 15; return 8 * (i >> 2) + 4 * n + (i & 3); }

struct Unit { int pm, pn, pn2, aux; };
struct Gemm { const bf16_t* A; const bf16_t* Bt; int M, N, K, ldb; };

struct StaticOrder {
    int nM, nN, nwg, G, c;
    __host__ __device__ void init(int M, int N, int G_, int c_) { nM = M / BM; nN = N / BM; nwg = nM * nN; G = G_; c = c_; }
    __host__ __device__ bool next(int i, Unit& u) const {
        const long L = (long)i * G + c; if (L >= nwg) return false;
        int wgid = (int)L; { const int q = nwg / NXCD, r = nwg % NXCD, xcd = wgid % NXCD, off = wgid / NXCD; wgid = (xcd < r ? xcd * (q + 1) : r * (q + 1) + (xcd - r) * q) + off; }
        const int nig = WGM * nN, gid = wgid / nig, fm = gid * WGM, gsz = (nM - fm) < WGM ? (nM - fm) : WGM;
        u.pm = fm + ((wgid % nig) % gsz); u.pn = (wgid % nig) / gsz; u.pn2 = 0; u.aux = 0; return true;
    }
    __device__ __forceinline__ int arow(const Unit&, int) const { return 0; }
    __device__ __forceinline__ void a_ready(const Unit&) const {}
    __device__ __forceinline__ void done(const Unit&) const {}
};

template <class Epi, class Sched, bool ALIGN_EPI, bool GATHER, bool SPLITB = false, bool I8 = false>
__device__ __forceinline__ void gemm_phase(PG8_LAS unsigned char* lds, const int wid, const Gemm g, const Sched& S, const Epi& E) {
    const int lane = cur_lane(), tid = wid * 64 + lane, wr = wid >> 2, wc = wid & 3, fr = lane & 15, fq = lane >> 4;
    const int K = g.K, nt = K / BK, ldb = g.ldb ? g.ldb : K;
    unsigned voffA[2], voffB[2]; int Rr[2], Cc[2];
#pragma unroll
    for (int i = 0; i < 2; ++i) { int R, C; stage_rc(tid * 16 + i * 8192, R, C); const int Rb = Epi::PERM ? ((R & ~31) + perm32(R & 31)) : R;
        Rr[i] = R; Cc[i] = C; voffA[i] = (unsigned)(R * K + C) * 2u; voffB[i] = (unsigned)(Rb * ldb + C) * 2u; }
    const size_t kstep = (size_t)(BK * 2);
    const size_t hstep = (size_t)HALF * K * 2;
    const size_t tstep = 2 * hstep;
    const size_t hstepB = (size_t)HALF * ldb * 2, tstepB = 2 * hstepB;
    const unsigned ldsb = (unsigned)(unsigned long long)lds + (unsigned)wid * 1024u;
    const int aoff = lds_byte(wr * 64 + fr, fq * 8), boff = lds_byte(wc * 32 + fr, fq * 8);
#define PG8_SA(b, h) (((b) * 2 + (h)) * HTB)
#define PG8_SB(b, h) ((4 + (b) * 2 + (h)) * HTB)
#define PG8_STAGE(bufoff, gbase, voff) do { _Pragma("unroll") for (int _i = 0; _i < 2; ++_i) \
        glds16((const char*)(gbase) + (voff)[_i], ldsb + (unsigned)((bufoff) + _i * 8192)); } while (0)
#define PG8_STAGE_A(bufoff, kp, h, vs) do { if constexpr (GATHER) { PG8_STAGE(bufoff, kp, vs[h]); } else { PG8_STAGE(bufoff, (kp) + (h) * hstep, voffA); } } while (0)
#define PG8_LDA(dst, b, h) do { _Pragma("unroll") for (int m = 0; m < 4; ++m) _Pragma("unroll") for (int k = 0; k < 2; ++k) dst[m][k] = *(const PG8_LAS bf16x8*)(lds + PG8_SA(b, h) + aoff + m * 2048 + k * 1024); } while (0)
#define PG8_LDB(dst, b, h) do { _Pragma("unroll") for (int n = 0; n < 2; ++n) _Pragma("unroll") for (int k = 0; k < 2; ++k) dst[n][k] = *(const PG8_LAS bf16x8*)(lds + PG8_SB(b, h) + boff + n * 2048 + k * 1024); } while (0)
#define PG8_MMA(ai, bj, At, Bt) do { __builtin_amdgcn_s_setprio(1); _Pragma("unroll") for (int m = 0; m < 4; ++m) _Pragma("unroll") for (int n = 0; n < 2; ++n) _Pragma("unroll") for (int k = 0; k < 2; ++k) \
        { if constexpr (I8) acc[ai][bj][m][n] = __builtin_bit_cast(f32x4, __builtin_amdgcn_mfma_i32_16x16x64_i8(__builtin_bit_cast(i32x4, Bt[n][k]), __builtin_bit_cast(i32x4, At[m][k]), __builtin_bit_cast(i32x4, acc[ai][bj][m][n]), 0, 0, 0)); \
          else acc[ai][bj][m][n] = __builtin_amdgcn_mfma_f32_16x16x32_bf16(Bt[n][k], At[m][k], acc[ai][bj][m][n], 0, 0, 0); } __builtin_amdgcn_s_setprio(0); } while (0)
#define PG8_WAIT_V(n) asm volatile("s_waitcnt vmcnt(" #n ")" ::: "memory")
#define PG8_WAIT_L(n) asm volatile("s_waitcnt lgkmcnt(" #n ")" ::: "memory")
#define PG8_BAR __builtin_amdgcn_s_barrier()
#define PG8_SCHED __builtin_amdgcn_sched_barrier(0)
    Unit cur, nxt; int ui = 0;
    if (!S.next(0, cur)) return;
    PG8_LAS int* rowtab = (PG8_LAS int*)(lds + STAGE_BYTES);
    unsigned vAc[2][2], vAn[2][2], vS[2][2];
    if constexpr (GATHER) {
        Unit uu;
        for (int i = 0; i < MAXU; ++i) { if (!S.next(i, uu)) break; if (tid < 256) rowtab[i * 256 + tid] = S.arow(uu, tid); }
        asm volatile("s_waitcnt vmcnt(0) lgkmcnt(0)" ::: "memory"); __builtin_amdgcn_s_barrier(); asm volatile("" ::: "memory");
#pragma unroll
        for (int h = 0; h < 2; ++h)
#pragma unroll
            for (int i = 0; i < 2; ++i) { vAc[h][i] = (unsigned)(rowtab[h * 128 + Rr[i]] * K + Cc[i]) * 2u; vAn[h][i] = vAc[h][i]; vS[h][i] = vAc[h][i]; }
    }
    f32x4 acc[2][2][4][2];
#pragma unroll
    for (int a = 0; a < 2; ++a)
#pragma unroll
        for (int b = 0; b < 2; ++b)
#pragma unroll
            for (int m = 0; m < 4; ++m)
#pragma unroll
                for (int n = 0; n < 2; ++n) acc[a][b][m][n] = (f32x4){0.f, 0.f, 0.f, 0.f};
    bf16x8 At[4][2], B0[2][2], B1[2][2];
    const char* cA = GATHER ? (const char*)g.A : (const char*)g.A + (size_t)cur.pm * tstep; const char* cB = (const char*)g.Bt + (size_t)cur.pn * tstepB; const char* cB2 = (const char*)g.Bt + (size_t)cur.pn2 * tstepB;
    S.a_ready(cur);
    PG8_STAGE(PG8_SB(0, 0), cB, voffB); PG8_STAGE(PG8_SB(0, 1), cB + hstepB, voffB); PG8_STAGE_A(PG8_SA(0, 0), cA, 0, vAc); PG8_STAGE_A(PG8_SA(0, 1), cA, 1, vAc);
    if (wr == 1) PG8_BAR;
    PG8_WAIT_V(2); PG8_BAR;
    PG8_STAGE(PG8_SB(1, 0), cB + kstep, voffB); PG8_STAGE_A(PG8_SA(1, 0), cA + kstep, 0, vAc); PG8_STAGE(PG8_SB(1, 1), cB + hstepB + kstep, voffB);
    PG8_WAIT_V(6); PG8_BAR;
    for (;;) {
        const bool has_next = S.next(ui + 1, nxt);
        const char* nA = GATHER ? cA : (has_next ? (const char*)g.A + (size_t)nxt.pm * tstep : cA); const char* nB = has_next ? (const char*)g.Bt + (size_t)nxt.pn * tstepB : cB; const char* nB2 = has_next ? (const char*)g.Bt + (size_t)nxt.pn2 * tstepB : cB2;
        if constexpr (GATHER) {
            if (has_next) {
#pragma unroll
                for (int h = 0; h < 2; ++h)
#pragma unroll
                    for (int i = 0; i < 2; ++i) vAn[h][i] = (unsigned)(rowtab[(ui + 1) * 256 + h * 128 + Rr[i]] * K + Cc[i]) * 2u;
            }
        }
        for (int t = 0; t < nt; t += 2) {
            const bool last = (t == nt - 2);
            const char* a1 = cA + (size_t)(t + 1) * kstep;
            const char* a2 = last ? nA : cA + (size_t)(t + 2) * kstep; const char* b2 = last ? nB : (SPLITB ? cB2 : cB + (size_t)(t + 2) * kstep);
            const char* a3 = a2 + kstep; const char* b3 = b2 + kstep;
            if constexpr (GATHER) {
#pragma unroll
                for (int h = 0; h < 2; ++h)
#pragma unroll
                    for (int i = 0; i < 2; ++i) vS[h][i] = last ? vAn[h][i] : vAc[h][i];
            }
            if (last && has_next) S.a_ready(nxt);
            PG8_LDB(B0, 0, 0); PG8_LDB(B1, 0, 1); PG8_SCHED; PG8_LDA(At, 0, 0); PG8_STAGE_A(PG8_SA(1, 1), a1, 1, vAc);
            PG8_WAIT_V(8); PG8_WAIT_L(0); PG8_BAR; PG8_MMA(0, 0, At, B0); PG8_MMA(0, 1, At, B1); PG8_BAR; PG8_SCHED;
            PG8_LDA(At, 0, 1); PG8_STAGE(PG8_SB(0, 0), b2, voffB); PG8_STAGE(PG8_SB(0, 1), b2 + hstepB, voffB); PG8_STAGE_A(PG8_SA(0, 0), a2, 0, vS);
            PG8_WAIT_V(8); PG8_WAIT_L(0); PG8_BAR; PG8_MMA(1, 0, At, B0); PG8_MMA(1, 1, At, B1); PG8_BAR; PG8_SCHED;
            PG8_LDB(B0, 1, 0); PG8_LDB(B1, 1, 1); PG8_SCHED; PG8_LDA(At, 1, 0); PG8_STAGE_A(PG8_SA(0, 1), a2, 1, vS);
            PG8_WAIT_V(8); PG8_WAIT_L(0); PG8_BAR; PG8_MMA(0, 0, At, B0); PG8_MMA(0, 1, At, B1); PG8_BAR; PG8_SCHED;
            PG8_LDA(At, 1, 1); PG8_STAGE(PG8_SB(1, 0), b3, voffB); PG8_STAGE(PG8_SB(1, 1), b3 + hstepB, voffB); PG8_STAGE_A(PG8_SA(1, 0), a3, 0, vS);
            PG8_WAIT_V(8); PG8_WAIT_L(0); PG8_BAR; PG8_MMA(1, 0, At, B0); PG8_MMA(1, 1, At, B1); PG8_BAR; PG8_SCHED;
        }
        if constexpr (ALIGN_EPI) { if (wr == 0) PG8_BAR; }
        E(acc, cur, wr, wc, fr, fq); S.done(cur);
        if (!has_next) break;
        if (!E.keep(cur))
#pragma unroll
        for (int a = 0; a < 2; ++a)
#pragma unroll
            for (int b = 0; b < 2; ++b)
#pragma unroll
                for (int m = 0; m < 4; ++m)
#pragma unroll
                    for (int n = 0; n < 2; ++n) acc[a][b][m][n] = (f32x4){0.f, 0.f, 0.f, 0.f};
        cur = nxt; cA = nA; cB = nB; cB2 = nB2; ++ui;
        if constexpr (GATHER) {
#pragma unroll
            for (int h = 0; h < 2; ++h)
#pragma unroll
                for (int i = 0; i < 2; ++i) vAc[h][i] = vAn[h][i];
        }
        if constexpr (ALIGN_EPI) { if (wr == 1) PG8_BAR; }
    }
    PG8_WAIT_V(0);
    if constexpr (!ALIGN_EPI) { if (wr == 0) PG8_BAR; }
    PG8_BAR;
#undef PG8_SA
#undef PG8_SB
#undef PG8_STAGE
#undef PG8_STAGE_A
#undef PG8_LDA
#undef PG8_LDB
#undef PG8_MMA
#undef PG8_WAIT_V
#undef PG8_WAIT_L
#undef PG8_BAR
#undef PG8_SCHED
}
}

#define XB_TMO      128
#define XB_XCNT(j)  (256  + 64 * (j))
#define XB_XSUB(j)  (1280 + 64 * (j))
#define XB_XGEN(j)  (2304 + 64 * (j))
#define XB_TOP      3328
#define XB_TOPGEN   3392
#define XCD_BAR_WORDS 3456
#define XB_SPIN_CAP (1u << 18)

__device__ __forceinline__ unsigned xb_ld(unsigned* p)              { return __hip_atomic_load(p, __ATOMIC_RELAXED, __HIP_MEMORY_SCOPE_AGENT); }
__device__ __forceinline__ unsigned xb_add(unsigned* p, unsigned v) { return __hip_atomic_fetch_add(p, v, __ATOMIC_RELAXED, __HIP_MEMORY_SCOPE_AGENT); }
__device__ __forceinline__ unsigned xb_xcc_id() { return (unsigned)__builtin_amdgcn_s_getreg((3 << 11) | 20) & 0xFu; }
#define XB_SPIN(cond, bar) do { unsigned _sp = 0; while (cond) { __builtin_amdgcn_s_sleep(1); \
    if ((++_sp & 255u) == 0u) { if (xb_ld(&(bar)[XB_TMO])) break; if (_sp > XB_SPIN_CAP) { atomicAdd(&(bar)[XB_TMO], 1u); break; } } } } while (0)

struct XcdBarrier {
    unsigned* bar; unsigned x;
    volatile LAS unsigned* st;
};
__device__ __forceinline__ XcdBarrier xcd_barrier_post(unsigned* bar, volatile LAS unsigned* st) {
    XcdBarrier b; b.bar = bar; b.x = xb_xcc_id(); b.st = st;
    if (threadIdx.x == 0) (void)xb_add(&bar[XB_XCNT(b.x)], 1u);
    return b;
}
__device__ __forceinline__ void xcd_barrier_complete(unsigned* bar, unsigned x, unsigned& nloc, unsigned& nx) {
    const unsigned G = gridDim.x * gridDim.y * gridDim.z;
    unsigned sum, cnt, mine, sp = 0u;
    for (;;) {
        sum = 0u; cnt = 0u; mine = 0u;
#pragma unroll
        for (unsigned j = 0; j < 16; ++j) { const unsigned c = xb_ld(&bar[XB_XCNT(j)]); sum += c; cnt += (c > 0u) ? 1u : 0u; mine = (j == x) ? c : mine; }
        if (sum == G) break;
        __builtin_amdgcn_s_sleep(1);
        if ((++sp & 255u) == 0u) { if (xb_ld(&bar[XB_TMO])) break; if (sp > XB_SPIN_CAP) { atomicAdd(&bar[XB_TMO], 1u); break; } }
    }
    nloc = mine > 0u ? mine : 1u; nx = cnt > 0u ? cnt : 1u;
}
__device__ __forceinline__ void xcd_barrier(const XcdBarrier& b, const bool thread0) {
    asm volatile("s_waitcnt vmcnt(0)" ::: "memory");
    __syncthreads();
    if (thread0) {
        unsigned* bar = b.bar;
        __builtin_amdgcn_s_waitcnt(0);
        unsigned nloc = b.st[0], nx = b.st[1];
        if (nloc == 0u) { xcd_barrier_complete(bar, b.x, nloc, nx); b.st[0] = nloc; b.st[1] = nx; }
        const unsigned old = xb_add(&bar[XB_XSUB(b.x)], 1u);
        const unsigned gen = old / nloc;
        if (old + 1u == (gen + 1u) * nloc) {
            __builtin_amdgcn_fence(__ATOMIC_RELEASE, "agent");
            asm volatile("s_waitcnt vmcnt(0)" ::: "memory");
            const unsigned og = xb_add(&bar[XB_TOP], 1u);
            const unsigned tg = og / nx;
            if (og + 1u == (tg + 1u) * nx) xb_add(&bar[XB_TOPGEN], 1u);
            else XB_SPIN(xb_ld(&bar[XB_TOPGEN]) == tg, bar);
            __builtin_amdgcn_fence(__ATOMIC_ACQUIRE, "agent");
            xb_add(&bar[XB_XGEN(b.x)], 1u);
            asm volatile("s_waitcnt vmcnt(0)" ::: "memory");
        } else {
            XB_SPIN(xb_ld(&bar[XB_XGEN(b.x)]) == gen, bar);
            __builtin_amdgcn_fence(__ATOMIC_ACQUIRE, "agent");
            asm volatile("s_waitcnt vmcnt(0)" ::: "memory");
        }
    }
    __syncthreads();
}

using pg8::Unit;
struct EpiProj {
    static constexpr bool PERM = true;
    __device__ __forceinline__ bool keep(const Unit&) const { return false; }
    bf16 *PA, *Q, *Kb, *UC; unsigned char* GATE; const float* bgate; const LAS unsigned char* sigt; const float* rs; const float* cs;
    __device__ __forceinline__ void operator()(f32x4 (&acc)[2][2][4][2], const Unit& u, int wr, int wc, int fr, int fq) const {
        const int pn = u.pn; bf16* dst; int ldc, cb, act;
        if (pn < 3) { dst = PA; ldc = 768; cb = pn * 256; act = 0; }
        else if (pn == 3) { dst = Q; ldc = 256; cb = 0; act = 3; }
        else if (pn == 4) { dst = Kb; ldc = 256; cb = 0; act = 0; }
        else if (pn < 8) { dst = UC; ldc = 512; cb = (pn - 6) * 256; act = 1; }
        else { dst = PA; ldc = 0; cb = (pn - 8) * 256; act = 2; }
        const int row0 = u.pm * 256 + wr * 64 + fr, col0 = cb + wc * 32 + 8 * fq;
        unsigned char* gblk = GATE + ((size_t)(u.pm * 12 + (pn - 8)) << 16) + ((((wr * 4 + wc) * 4 + fq) * 16 + fr) << 3);
        f32x4 bv[2][2];
#pragma unroll
        for (int bj = 0; bj < 2; ++bj)
#pragma unroll
            for (int n = 0; n < 2; ++n) bv[bj][n] = *(const f32x4*)(bgate + (act == 2 ? col0 : 0) + bj * 128 + 4 * n);
#pragma unroll
        for (int ai = 0; ai < 2; ++ai)
#pragma unroll
            for (int m = 0; m < 4; ++m) { bf16* rowp = dst + (size_t)(row0 + ai * 128 + m * 16) * ldc + col0;
#pragma unroll
                for (int bj = 0; bj < 2; ++bj) { const i32x4 i0 = __builtin_bit_cast(i32x4, acc[ai][bj][m][0]), i1 = __builtin_bit_cast(i32x4, acc[ai][bj][m][1]); const float rsv = rs[row0 + ai * 128 + m * 16];
                    const f32x4 c0 = *(const f32x4*)(cs + u.pn * 256 + wc * 32 + 8 * fq + bj * 128), c1 = *(const f32x4*)(cs + u.pn * 256 + wc * 32 + 8 * fq + bj * 128 + 4);
                    f32x4 v0 = (f32x4){(float)i0[0], (float)i0[1], (float)i0[2], (float)i0[3]} * c0 * rsv, v1 = (f32x4){(float)i1[0], (float)i1[1], (float)i1[2], (float)i1[3]} * c1 * rsv;
                    if (act == 1) {
#pragma unroll
                        for (int j = 0; j < 4; ++j) { v0[j] = gelu_tanh(v0[j]); v1[j] = gelu_tanh(v1[j]); }
                    } else if (act == 2) { v0 = v0 + bv[bj][0]; v1 = v1 + bv[bj][1]; unsigned q[8];
#pragma unroll
                        for (int j = 0; j < 4; ++j) { q[j] = sigt[(int)__builtin_amdgcn_fmed3f(v0[j] * 128.f + 1024.f, 0.f, 2047.f)]; q[4 + j] = sigt[(int)__builtin_amdgcn_fmed3f(v1[j] * 128.f + 1024.f, 0.f, 2047.f)]; }
                        u32x2 w8; w8.x = q[0] | (q[1] << 8) | (q[2] << 16) | (q[3] << 24); w8.y = q[4] | (q[5] << 8) | (q[6] << 16) | (q[7] << 24);
                        *(u32x2*)(gblk + ((((ai * 4 + m) * 2 + bj)) << 12)) = w8; continue;
                    } else if (act == 3) { v0 = v0 * 0.18033688f; v1 = v1 * 0.18033688f; }
                    u32x4 w; w.x = cvt_pk_bf16(v0[0], v0[1]); w.y = cvt_pk_bf16(v0[2], v0[3]); w.z = cvt_pk_bf16(v1[0], v1[1]); w.w = cvt_pk_bf16(v1[2], v1[3]);
                    *(u32x4*)(rowp + bj * 128) = w; } }
        asm volatile("" :: "v"(bv[0][0]), "v"(bv[0][1]), "v"(bv[1][0]), "v"(bv[1][1]));
    }
};
struct EpiGate {
    static constexpr bool PERM = true;
    __device__ __forceinline__ bool keep(const Unit&) const { return false; }
    unsigned char* GATE; const float* bgate; const float* rs; const float* cs; const LAS unsigned char* sigt;
    __device__ __forceinline__ void operator()(f32x4 (&acc)[2][2][4][2], const Unit& u, int wr, int wc, int fr, int fq) const {
        const int row0 = u.pm * 256 + wr * 64 + fr, col0 = u.pn * 256 + wc * 32 + 8 * fq;
        unsigned char* gblk = GATE + ((size_t)(u.pm * 12 + u.pn) << 16) + ((((wr * 4 + wc) * 4 + fq) * 16 + fr) << 3);
        f32x4 bv[2][2], cv[2][2]; float rv[2][4];
#pragma unroll
        for (int bj = 0; bj < 2; ++bj)
#pragma unroll
            for (int n = 0; n < 2; ++n) { bv[bj][n] = *(const f32x4*)(bgate + col0 + bj * 128 + 4 * n); cv[bj][n] = *(const f32x4*)(cs + col0 + bj * 128 + 4 * n); }
#pragma unroll
        for (int ai = 0; ai < 2; ++ai)
#pragma unroll
            for (int m = 0; m < 4; ++m) rv[ai][m] = rs[row0 + ai * 128 + m * 16];
#pragma unroll
        for (int ai = 0; ai < 2; ++ai)
#pragma unroll
            for (int m = 0; m < 4; ++m)
#pragma unroll
                for (int bj = 0; bj < 2; ++bj) { const i32x4 i0 = __builtin_bit_cast(i32x4, acc[ai][bj][m][0]), i1 = __builtin_bit_cast(i32x4, acc[ai][bj][m][1]); unsigned q[8];
#pragma unroll
                    for (int j = 0; j < 4; ++j) { const float v0 = (float)i0[j] * (rv[ai][m] * cv[bj][0][j]) + bv[bj][0][j], v1 = (float)i1[j] * (rv[ai][m] * cv[bj][1][j]) + bv[bj][1][j];
                        q[j] = sigt[(int)__builtin_amdgcn_fmed3f(v0 * 128.f + 1024.f, 0.f, 2047.f)]; q[4 + j] = sigt[(int)__builtin_amdgcn_fmed3f(v1 * 128.f + 1024.f, 0.f, 2047.f)]; }
                    u32x2 w8; w8.x = q[0] | (q[1] << 8) | (q[2] << 16) | (q[3] << 24); w8.y = q[4] | (q[5] << 8) | (q[6] << 16) | (q[7] << 24);
                    *(u32x2*)(gblk + ((((ai * 4 + m) * 2 + bj)) << 12)) = w8; }
    }
};
struct EpiVt {
    static constexpr bool PERM = true;
    __device__ __forceinline__ bool keep(const Unit&) const { return false; }
    bf16* VT; const float* rs; const float* cs;
    __device__ __forceinline__ void operator()(f32x4 (&acc)[2][2][4][2], const Unit& u, int wr, int wc, int fr, int fq) const {
        const int row0 = wr * 64 + fr, col0 = u.pn * 256 + wc * 32 + 8 * fq;
#pragma unroll
        for (int ai = 0; ai < 2; ++ai)
#pragma unroll
            for (int m = 0; m < 4; ++m) { const int dg = row0 + ai * 128 + m * 16;
                bf16* rowp = VT + ((size_t)(dg >> 6) * (T / 32) * 64 + (dg & 63)) * 32 + (size_t)(col0 >> 5) * 2048 + (col0 & 31);
#pragma unroll
                for (int bj = 0; bj < 2; ++bj) { const i32x4 i0 = __builtin_bit_cast(i32x4, acc[ai][bj][m][0]), i1 = __builtin_bit_cast(i32x4, acc[ai][bj][m][1]); const float csv = cs[1280 + dg];
                    const f32x4 r0 = *(const f32x4*)(rs + col0 + bj * 128), r1 = *(const f32x4*)(rs + col0 + bj * 128 + 4);
                    const f32x4 v0 = (f32x4){(float)i0[0], (float)i0[1], (float)i0[2], (float)i0[3]} * r0 * csv, v1 = (f32x4){(float)i1[0], (float)i1[1], (float)i1[2], (float)i1[3]} * r1 * csv;
                    u32x4 w; w.x = cvt_pk_bf16(v0[0], v0[1]); w.y = cvt_pk_bf16(v0[2], v0[3]); w.z = cvt_pk_bf16(v1[0], v1[1]); w.w = cvt_pk_bf16(v1[2], v1[3]);
                    *(u32x4*)(rowp + bj * 4 * 2048) = w; } }
    }
};
struct EpiMerge {
    static constexpr bool PERM = true;
    const unsigned char* GATE; bf16* MG;
    __device__ __forceinline__ bool keep(const Unit& u) const { return (u.pn >> 2) < 2; }
    __device__ __forceinline__ void operator()(f32x4 (&acc)[2][2][4][2], const Unit& u, int wr, int wc, int fr, int fq) const {
        const int br = u.pn >> 2, pm = u.pm - br * (T / 256), pn = u.pn & 3;
        const int row0 = pm * 256 + wr * 64 + fr, col0 = pn * 256 + wc * 32 + 8 * fq;
        const unsigned char* gbase = GATE + ((size_t)(pm * 12 + br * 4 + pn) << 16) + ((((wr * 4 + wc) * 4 + fq) * 16 + fr) << 3); const int gnext = br < 2 ? (4 << 16) : 0;
        u32x2 ga[4][2][2], gb[4][2][2];
#define EM_LOAD(hb) do { _Pragma("unroll") for (int mm = 0; mm < 2; ++mm) _Pragma("unroll") for (int bj = 0; bj < 2; ++bj) { \
            const unsigned char* gp = gbase + ((((((hb) >> 1) * 4 + 2 * ((hb) & 1) + mm) * 2 + bj)) << 12); \
            ga[hb][mm][bj] = *(const u32x2*)gp; gb[hb][mm][bj] = *(const u32x2*)(gp + gnext); } asm volatile("" ::: "memory"); } while (0)
#define EM_COMP(hb) do { _Pragma("unroll") for (int mm = 0; mm < 2; ++mm) _Pragma("unroll") for (int bj = 0; bj < 2; ++bj) { \
            constexpr int ai = (hb) >> 1; const int m = 2 * ((hb) & 1) + mm; const u32x2 a = ga[hb][mm][bj], b = gb[hb][mm][bj]; float s[8]; \
            _Pragma("unroll") for (int q = 0; q < 8; ++q) { float av = (float)((a[q >> 2] >> (8 * (q & 3))) & 0xffu); const float bv_ = (float)((b[q >> 2] >> (8 * (q & 3))) & 0xffu); \
                if (br > 0) av = fmaxf(av, 1.f);                        \
                if (br < 2) av *= __builtin_amdgcn_rcpf(fmaxf(bv_, 1.f)); else av *= (1.f / 255.f); \
                s[q] = av; } \
            f32x4 v0 = acc[ai][bj][m][0], v1 = acc[ai][bj][m][1]; \
            v0[0] *= s[0]; v0[1] *= s[1]; v0[2] *= s[2]; v0[3] *= s[3]; v1[0] *= s[4]; v1[1] *= s[5]; v1[2] *= s[6]; v1[3] *= s[7]; \
            if (br < 2) { acc[ai][bj][m][0] = v0; acc[ai][bj][m][1] = v1; } \
            else { u32x4 w; w.x = cvt_pk_bf16(v0[0], v0[1]); w.y = cvt_pk_bf16(v0[2], v0[3]); w.z = cvt_pk_bf16(v1[0], v1[1]); w.w = cvt_pk_bf16(v1[2], v1[3]); \
                *(u32x4*)(MG + (size_t)(row0 + ai * 128 + m * 16) * 1024 + col0 + bj * 128) = w; } } asm volatile("" ::: "memory"); } while (0)
        EM_LOAD(0); EM_LOAD(1); EM_COMP(0); EM_LOAD(2); EM_COMP(1); EM_LOAD(3); EM_COMP(2); EM_COMP(3);
#undef EM_LOAD
#undef EM_COMP
    }
};
struct EpiWo {
    static constexpr bool PERM = true;
    __device__ __forceinline__ bool keep(const Unit&) const { return false; }
    const bf16* HB; bf16* out;
    __device__ __forceinline__ void operator()(f32x4 (&acc)[2][2][4][2], const Unit& u, int wr, int wc, int fr, int fq) const {
        const int row0 = u.pm * 256 + wr * 64 + fr, col0 = u.pn * 256 + wc * 32 + 8 * fq;
        u32x4 hv[4][2][2];
#define EW_LOAD(hb) do { _Pragma("unroll") for (int mm = 0; mm < 2; ++mm) _Pragma("unroll") for (int bj = 0; bj < 2; ++bj) \
            hv[hb][mm][bj] = *(const u32x4*)(HB + (size_t)(row0 + ((hb) >> 1) * 128 + (2 * ((hb) & 1) + mm) * 16) * DM + col0 + bj * 128); asm volatile("" ::: "memory"); } while (0)
#define EW_COMP(hb) do { _Pragma("unroll") for (int mm = 0; mm < 2; ++mm) _Pragma("unroll") for (int bj = 0; bj < 2; ++bj) { \
            constexpr int ai = (hb) >> 1; const int m = 2 * ((hb) & 1) + mm; const u32x4 h = hv[hb][mm][bj]; bf16* op = out + (size_t)(row0 + ai * 128 + m * 16) * DM + col0 + bj * 128; \
            const f32x4 h0 = (f32x4){bf_lo(h.x), bf_hi(h.x), bf_lo(h.y), bf_hi(h.y)}, h1 = (f32x4){bf_lo(h.z), bf_hi(h.z), bf_lo(h.w), bf_hi(h.w)}; \
            const f32x4 p0 = h0 * ALPHA + acc[ai][bj][m][0], p1 = h1 * ALPHA + acc[ai][bj][m][1]; \
            u32x4 w; w.x = cvt_pk_bf16(p0[0], p0[1]); w.y = cvt_pk_bf16(p0[2], p0[3]); w.z = cvt_pk_bf16(p1[0], p1[1]); w.w = cvt_pk_bf16(p1[2], p1[3]); *(u32x4*)op = w; } asm volatile("" ::: "memory"); } while (0)
        EW_LOAD(0); EW_LOAD(1); EW_LOAD(2); EW_COMP(0); EW_LOAD(3); EW_COMP(1); EW_COMP(2); EW_COMP(3);
#undef EW_LOAD
#undef EW_COMP
    }
};
constexpr int NBK = 24;
__device__ __forceinline__ void moe_build(LAS int* mt, gu32* gcnt, int tid) {
    if (tid < NBK) mt[tid] = (int)__hip_atomic_load(gcnt + tid, RLX_AGENT);
    __syncthreads();
    if (tid == 0) { int a = 0; for (int j = 0; j < NBK; ++j) { mt[32 + j] = a; a += (mt[j] + 255) >> 8; } mt[56] = a; }
    __syncthreads();
}
__device__ __forceinline__ int mtu(const LAS int* mt, int i) { return __builtin_amdgcn_readfirstlane(mt[i]); }
__device__ __forceinline__ int moe_bucket_of(const LAS int* mt, int rt) {
    const int lane = cur_lane(); const bool p = lane < NBK && rt >= mt[33 + (lane < NBK ? lane : 0)];
    return (int)__popcll(__ballot(p));
}
template <int SH>
struct MoeOrder {
    const LAS int* mt; int G, c, ntile; const int* perm;
    __device__ __forceinline__ bool next(int i, Unit& u) const {
        const long L = (long)i * G + c; if (L >= ((long)ntile << SH)) return false;
        const int rt = (int)(L >> SH), q = (int)(L & ((1 << SH) - 1)), b = moe_bucket_of(mt, rt), g = b / 6, pi = b - 6 * g;
        const int lo = pi < 3 ? 0 : pi < 5 ? 1 : 2, hi = pi < 3 ? pi + 1 : pi < 5 ? pi - 1 : 3;
        u.pm = rt;
        if (SH == 1) { u.pn = 4 * g + (q ? hi : lo); u.pn2 = 0; u.aux = b * 2 + q; }
        else { u.pn = (4 * g + lo) * 4 + q; u.pn2 = (4 * g + hi) * 4 + q; u.aux = b * 4 + q; }
        return true;
    }
    __device__ __forceinline__ int arow(const Unit& u, int r) const {
        const int b = u.aux >> SH, slot = (u.pm - mtu(mt, 32 + b)) * 256 + r;
        return slot < mtu(mt, b) ? perm[(size_t)b * T + slot] : 0;
    }
    __device__ __forceinline__ void a_ready(const Unit&) const {}
    __device__ __forceinline__ void done(const Unit&) const {}
};
struct EpiMoeUp {
    static constexpr bool PERM = true;
    __device__ __forceinline__ bool keep(const Unit&) const { return false; }
    const LAS int* mt; const float* dwp; bf16* HID; const float* csu;
    __device__ __forceinline__ void operator()(f32x4 (&acc)[2][2][4][2], const Unit& u, int wr, int wc, int fr, int fq) const {
        const int b = u.aux >> 1, q = u.aux & 1, tb = mtu(mt, 32 + b), cnt = mtu(mt, b);
        const int r0 = wr * 64 + fr, f0 = wc * 32 + 8 * fq, col0 = q * 128 + f0;
        float dwv[2][4], rsv[2][4];
#pragma unroll
        for (int ai = 0; ai < 2; ++ai)
#pragma unroll
            for (int m = 0; m < 4; ++m) { const int slot = (u.pm - tb) * 256 + r0 + ai * 128 + m * 16; const f32x4 dv = *(const f32x4*)(dwp + ((size_t)b * T + (slot < cnt ? slot : 0)) * 4);
                dwv[ai][m] = slot < cnt ? (q ? dv.y : dv.x) : 0.f; rsv[ai][m] = slot < cnt ? dv.z : 0.f; }
        const f32x4 cg0 = *(const f32x4*)(csu + u.pn * 256 + f0), cg1 = *(const f32x4*)(csu + u.pn * 256 + f0 + 4), cu0 = *(const f32x4*)(csu + u.pn * 256 + 128 + f0), cu1 = *(const f32x4*)(csu + u.pn * 256 + 128 + f0 + 4);
#pragma unroll
        for (int ai = 0; ai < 2; ++ai)
#pragma unroll
            for (int m = 0; m < 4; ++m) { const int r = r0 + ai * 128 + m * 16; const float dw = dwv[ai][m], rs_ = rsv[ai][m];
                const i32x4 ig0 = __builtin_bit_cast(i32x4, acc[ai][0][m][0]), ig1 = __builtin_bit_cast(i32x4, acc[ai][0][m][1]), iu0 = __builtin_bit_cast(i32x4, acc[ai][1][m][0]), iu1 = __builtin_bit_cast(i32x4, acc[ai][1][m][1]);
                float h[8];
#pragma unroll
                for (int j = 0; j < 4; ++j) { const float g0 = (float)ig0[j] * (rs_ * cg0[j]), g1 = (float)ig1[j] * (rs_ * cg1[j]), u0 = (float)iu0[j] * (rs_ * cu0[j]), u1 = (float)iu1[j] * (rs_ * cu1[j]);
                    h[j] = g0 * sigmoid_fast(g0) * u0 * dw; h[4 + j] = g1 * sigmoid_fast(g1) * u1 * dw; }
                u32x4 w; w.x = cvt_pk_bf16(h[0], h[1]); w.y = cvt_pk_bf16(h[2], h[3]); w.z = cvt_pk_bf16(h[4], h[5]); w.w = cvt_pk_bf16(h[6], h[7]);
                *(u32x4*)(HID + (size_t)(u.pm * 256 + r) * 256 + col0) = w; }
    }
};
struct EpiMoeDown {
    static constexpr bool PERM = true;
    __device__ __forceinline__ bool keep(const Unit&) const { return false; }
    const LAS int* mt; const int* perm; const bf16* HB; bf16* out;
    __device__ __forceinline__ void operator()(f32x4 (&acc)[2][2][4][2], const Unit& u, int wr, int wc, int fr, int fq) const {
        const int b = u.aux >> 2, pn = u.aux & 3, tb = mtu(mt, 32 + b), cnt = mtu(mt, b);
        const int r0 = wr * 64 + fr, col0 = pn * 256 + wc * 32 + 8 * fq;
        int tok[2][4];
#pragma unroll
        for (int ai = 0; ai < 2; ++ai)
#pragma unroll
            for (int m = 0; m < 4; ++m) { const int slot = (u.pm - tb) * 256 + r0 + ai * 128 + m * 16; const int tk = perm[(size_t)b * T + (slot < cnt ? slot : 0)]; tok[ai][m] = slot < cnt ? tk : -1; }
#pragma unroll
        for (int ai = 0; ai < 2; ++ai) {
            u32x4 hv[4][2];
#pragma unroll
            for (int m = 0; m < 4; ++m) { const int tk = tok[ai][m] >= 0 ? tok[ai][m] : 0;
#pragma unroll
                for (int bj = 0; bj < 2; ++bj) hv[m][bj] = *(const u32x4*)(HB + (size_t)tk * DM + col0 + bj * 128); }
#pragma unroll
            for (int m = 0; m < 4; ++m) {
#pragma unroll
                for (int bj = 0; bj < 2; ++bj) { const u32x4 h = hv[m][bj];
                    const f32x4 h0 = (f32x4){bf_lo(h.x), bf_hi(h.x), bf_lo(h.y), bf_hi(h.y)}, h1 = (f32x4){bf_lo(h.z), bf_hi(h.z), bf_lo(h.w), bf_hi(h.w)};
                    const f32x4 p0 = h0 * ALPHA + acc[ai][bj][m][0], p1 = h1 * ALPHA + acc[ai][bj][m][1];
                    u32x4 w; w.x = cvt_pk_bf16(p0[0], p0[1]); w.y = cvt_pk_bf16(p0[2], p0[3]); w.z = cvt_pk_bf16(p1[0], p1[1]); w.w = cvt_pk_bf16(p1[2], p1[3]);
                    if (tok[ai][m] >= 0) *(u32x4*)(out + (size_t)tok[ai][m] * DM + col0 + bj * 128) = w; } }
            asm volatile("" ::: "memory"); }
    }
};
struct ProjOrder : pg8::StaticOrder {
    __device__ __forceinline__ bool next(int i, Unit& u) const { if (!pg8::StaticOrder::next(i, u)) return false; u.pn += (u.pn >= 5) ? 1 : 0; return true; }
};
struct MergeOrder {
    pg8::StaticOrder S;
    __device__ __forceinline__ bool next(int i, Unit& u) const { const int ti = i / 3, br = i - ti * 3; if (!S.next(ti, u)) return false; u.pm += br * (T / 256); u.pn += br * 4; u.pn2 = 0; u.aux = 0; return true; }
    __device__ __forceinline__ int arow(const Unit&, int) const { return 0; }
    __device__ __forceinline__ void a_ready(const Unit&) const {}
    __device__ __forceinline__ void done(const Unit&) const {}
};

struct Frame {
    LAS unsigned char* lds;
    volatile LAS unsigned* MISC;
    gu32* ctl;
    int tid, lane, wave, vcu, G, bx;
};

__device__ __forceinline__ void tr_block(const float* s, int lds_, bf16* d, int ldd, LAS float* scr, int lane) {
    f32x4 v[16];
#pragma unroll
    for (int i = 0; i < 16; ++i) v[i] = *(const f32x4*)(s + (size_t)(4 * i + (lane >> 4)) * lds_ + (lane & 15) * 4);
#pragma unroll
    for (int i = 0; i < 16; ++i) { LAS float* p = scr + (4 * i + (lane >> 4)) * 65 + (lane & 15) * 4; p[0] = v[i].x; p[1] = v[i].y; p[2] = v[i].z; p[3] = v[i].w; }
    LDS_WAIT(); asm volatile("" ::: "memory");
    const int c = lane & 7;
#pragma unroll
    for (int j = 0; j < 8; ++j) { const int n = (lane >> 3) + 8 * j; const LAS float* p = scr + (8 * c) * 65 + n;
        u32x4 o; o.x = cvt_pk_bf16(p[0 * 65], p[1 * 65]); o.y = cvt_pk_bf16(p[2 * 65], p[3 * 65]); o.z = cvt_pk_bf16(p[4 * 65], p[5 * 65]); o.w = cvt_pk_bf16(p[6 * 65], p[7 * 65]);
        *(u32x4*)(d + (size_t)n * ldd + 8 * c) = o; }
    LDS_WAIT(); asm volatile("" ::: "memory");
}
__device__ __forceinline__ void convert_strip8(const Frame& F0, const float* src, int sld, signed char* dst, float* csd) {
    Frame F = F0; F.wave = opqs(F0.wave); F.lane = cur_lane();
    LAS int* scr = (LAS int*)(F.lds + F.wave * 16896);
    LAS float* cmax = (LAS float*)(F.lds + 136192);
    const int c4 = (F.lane & 15) * 4, rg = F.lane >> 4;
    f32x4 v[2][16];
#pragma unroll
    for (int b = 0; b < 2; ++b)
#pragma unroll
        for (int i = 0; i < 16; ++i) v[b][i] = *(const f32x4*)(src + (size_t)(64 * (2 * F.wave + b) + 4 * i + rg) * sld + c4);
    f32x4 mx = (f32x4){0.f, 0.f, 0.f, 0.f};
#pragma unroll
    for (int b = 0; b < 2; ++b)
#pragma unroll
        for (int i = 0; i < 16; ++i) { mx.x = fmaxf(mx.x, fabsf(v[b][i].x)); mx.y = fmaxf(mx.y, fabsf(v[b][i].y)); mx.z = fmaxf(mx.z, fabsf(v[b][i].z)); mx.w = fmaxf(mx.w, fabsf(v[b][i].w)); }
#pragma unroll
    for (int o = 16; o < 64; o <<= 1) { mx.x = fmaxf(mx.x, shfl_xor_l(mx.x, o, F.lane)); mx.y = fmaxf(mx.y, shfl_xor_l(mx.y, o, F.lane)); mx.z = fmaxf(mx.z, shfl_xor_l(mx.z, o, F.lane)); mx.w = fmaxf(mx.w, shfl_xor_l(mx.w, o, F.lane)); }
    if (F.lane < 16) *(LAS f32x4*)(cmax + F.wave * 64 + c4) = mx;
    __syncthreads();
    f32x4 am = *(const LAS f32x4*)(cmax + c4);
#pragma unroll
    for (int w = 1; w < 8; ++w) { const f32x4 o = *(const LAS f32x4*)(cmax + w * 64 + c4); am.x = fmaxf(am.x, o.x); am.y = fmaxf(am.y, o.y); am.z = fmaxf(am.z, o.z); am.w = fmaxf(am.w, o.w); }
    am.x = fmaxf(am.x, 1e-30f); am.y = fmaxf(am.y, 1e-30f); am.z = fmaxf(am.z, 1e-30f); am.w = fmaxf(am.w, 1e-30f);
    const f32x4 inv = (f32x4){127.f / am.x, 127.f / am.y, 127.f / am.z, 127.f / am.w};
    if (F.wave == 0 && F.lane < 16) *(f32x4*)(csd + c4) = am * (1.f / 127.f);
#pragma unroll
    for (int b = 0; b < 2; ++b) {
#pragma unroll
        for (int i = 0; i < 16; ++i) { LAS int* p = scr + (4 * i + rg) * 65 + c4; p[0] = q8(v[b][i].x * inv.x); p[1] = q8(v[b][i].y * inv.y); p[2] = q8(v[b][i].z * inv.z); p[3] = q8(v[b][i].w * inv.w); }
        LDS_WAIT(); asm volatile("" ::: "memory");
        const int c8 = F.lane & 7;
#pragma unroll
        for (int j = 0; j < 8; ++j) { const int n = (F.lane >> 3) + 8 * j; const LAS int* p = scr + (8 * c8) * 65 + n;
            u32x2 o; o.x = pack4_i8(p[0 * 65], p[1 * 65], p[2 * 65], p[3 * 65]); o.y = pack4_i8(p[4 * 65], p[5 * 65], p[6 * 65], p[7 * 65]);
            *(u32x2*)(dst + (size_t)n * DM + 64 * (2 * F.wave + b) + 8 * c8) = o; }
        LDS_WAIT(); asm volatile("" ::: "memory");
    }
    __syncthreads();
}
__device__ __forceinline__ void convert_strip_item(const Frame& F, unsigned char* ws, int l, const float* w_in, const float* w_gate, const float* w_up, int s) {
    if (s < 80) convert_strip8(F, w_in + (size_t)l * DM * INC + 64 * s, INC, (signed char*)(ws + WS_WG8) + (size_t)64 * s * DM, (float*)(ws + WS_CS) + 64 * s);
    else { const int t = s - 80, e = t >> 2, up = (t >> 1) & 1, nb = t & 1;
        convert_strip8(F, (up ? w_up : w_gate) + ((size_t)l * 16 + e) * DM * 128 + 64 * nb, 128, (signed char*)(ws + WS_WU8) + (size_t)(e * 256 + up * 128 + 64 * nb) * DM, (float*)(ws + WS_CSU) + e * 256 + up * 128 + 64 * nb); }
}
__device__ __forceinline__ void convert_weights(const Frame& F0, unsigned char* ws, int l, const float* w_in, const float* w_br, const float* w_o, const float* w_gate, const float* w_up, const float* w_down, const float* sg_w, int part, int widx, int wcnt) {
    Frame F = F0; F.wave = opqs(F0.wave); F.vcu = opqs(F0.vcu); F.G = opqs(F0.G); F.lane = cur_lane(); F.tid = F.wave * 64 + F.lane;
    LAS float* scr = (LAS float*)(F.lds + F.wave * 16896);
    if (widx < 0) return;
    bf16* WIN = (bf16*)(ws + WS_WIN); bf16* WBR = (bf16*)(ws + WS_WBR); bf16* WO = (bf16*)(ws + WS_WO); bf16* WGU = (bf16*)(ws + WS_WGU); bf16* WD = (bf16*)(ws + WS_WD); bf16* SGW = (bf16*)(ws + WS_SGW);
    const float* win = w_in + (size_t)l * DM * INC; const float* wbr = w_br + (size_t)l * 3 * 256 * DM; const float* wo = w_o + (size_t)l * DM * DM;
    const float* wg = w_gate + (size_t)l * 16 * DM * 128; const float* wu = w_up + (size_t)l * 16 * DM * 128; const float* wd = w_down + (size_t)l * 16 * 128 * DM;
    constexpr int I_IN = 0, I_BR = 3 * 4 * 16, I_O = 16 * 16, I_G = 0, I_U = 0, I_D = 16 * 32;
    constexpr int NIT = I_IN + I_BR + I_O + I_G + I_U + I_D, NA = I_IN + I_BR + I_O;
    const int it0 = part == 2 ? NA : 0, it1 = part == 1 ? NA : NIT;
    for (int it = it0 + widx; it < it1; it += wcnt) {
        int r = it;
        if (r < I_IN) { const int kb = r / 32, nb = r % 32; tr_block(win + (size_t)(64 * kb) * INC + 64 * nb, INC, WIN + (size_t)(64 * nb) * DM + 64 * kb, DM, scr, F.lane); continue; } r -= I_IN;
        if (r < I_BR) { const int br = r / 64, q = r % 64, kb = q / 16, nb = q % 16; tr_block(wbr + (size_t)br * 256 * DM + (size_t)(64 * kb) * DM + 64 * nb, DM, WBR + (size_t)br * DM * 256 + (size_t)(64 * nb) * 256 + 64 * kb, 256, scr, F.lane); continue; } r -= I_BR;
        if (r < I_O) { const int kb = r / 16, nb = r % 16; tr_block(wo + (size_t)(64 * kb) * DM + 64 * nb, DM, WO + (size_t)(64 * nb) * DM + 64 * kb, DM, scr, F.lane); continue; } r -= I_O;
        if (r < I_G + I_U) { const bool up = r >= I_G; if (up) r -= I_G; const int e = r / 32, q = r % 32, kb = q / 2, nb = q % 2; const float* src = (up ? wu : wg) + (size_t)e * DM * 128;
            tr_block(src + (size_t)(64 * kb) * 128 + 64 * nb, 128, WGU + (size_t)(e >> 2) * DM * DM + (size_t)((e & 3) * 256 + (up ? 128 : 0) + 64 * nb) * DM + 64 * kb, DM, scr, F.lane); continue; } r -= I_G + I_U;
        { const int e = r / 32, q = r % 32, kb = q / 16, nb = q % 16;
          tr_block(wd + (size_t)e * 128 * DM + (size_t)(64 * kb) * DM + 64 * nb, DM, WD + (size_t)e * DM * 128 + (size_t)(64 * nb) * 128 + 64 * kb, 128, scr, F.lane); }
    }
    const float* sg = sg_w + (size_t)l * 4 * 128 * 128;
    if (part != 2) for (int i = widx * 64 + F.lane; i < 4 * 128 * 128 / 2; i += wcnt * 64) { const int e = 2 * i, t = (e >> 7) & 127, s = e & 127; const f32x2 v = *(const f32x2*)(sg + e);
        ((unsigned*)SGW)[i] = cvt_pk_bf16(s <= t ? v.x : 0.f, (s + 1) <= t ? v.y : 0.f); }
}

__device__ __forceinline__ void ln_row(const float* src, const f32x4 (&gm)[4], const f32x4 (&bt)[4], int lane, f32x4 (&y)[4]) {
    const f32x4* xr = (const f32x4*)src + lane; float s = 0.f;
#pragma unroll
    for (int j = 0; j < 4; ++j) { y[j] = xr[64 * j]; s += (y[j].x + y[j].y) + (y[j].z + y[j].w); }
    const float mean = wave_sum(s, lane) * (1.f / DM); float s2 = 0.f;
#pragma unroll
    for (int j = 0; j < 4; ++j) { y[j] = y[j] - mean; s2 += (y[j].x * y[j].x + y[j].y * y[j].y) + (y[j].z * y[j].z + y[j].w * y[j].w); }
    const float rstd = 1.f / sqrtf(wave_sum(s2, lane) * (1.f / DM) + LN_EPS);
#pragma unroll
    for (int j = 0; j < 4; ++j) y[j] = y[j] * rstd * gm[j] + bt[j];
}
__device__ __forceinline__ void store_row_q8(const f32x4 (&y)[4], unsigned char* o8, float* rsp, int lane) {
    float am = 0.f;
#pragma unroll
    for (int j = 0; j < 4; ++j) am = fmaxf(fmaxf(am, fmaxf(fabsf(y[j].x), fabsf(y[j].y))), fmaxf(fabsf(y[j].z), fabsf(y[j].w)));
    am = fmaxf(wave_max(am), 1e-20f); const float inv = 127.f / am;
#pragma unroll
    for (int j = 0; j < 4; ++j) *(unsigned*)(o8 + 256 * j + 4 * lane) = pack4_i8(q8(y[j].x * inv), q8(y[j].y * inv), q8(y[j].z * inv), q8(y[j].w * inv));
    if (lane == 0) *rsp = am * (1.f / 127.f);
}
template <bool WF32, bool WBF>
__device__ __forceinline__ void store_row(const f32x4 (&y)[4], float* of, bf16* ob, int lane) {
    f32x4* o4 = (f32x4*)of + lane; u32x2* o8 = (u32x2*)ob + lane;
#pragma unroll
    for (int j = 0; j < 4; ++j) { if (WF32) o4[64 * j] = y[j]; if (WBF) { u32x2 w; w.x = cvt_pk_bf16(y[j].x, y[j].y); w.y = cvt_pk_bf16(y[j].z, y[j].w); o8[64 * j] = w; } }
}
template <int NR>
__device__ __forceinline__ void ln_rows(const float* src, const f32x4 (&gm)[4], const f32x4 (&bt)[4], int lane, f32x4 (&y)[NR][4]) {
#pragma unroll
    for (int r = 0; r < NR; ++r) { const f32x4* xr = (const f32x4*)(src + (size_t)r * DM) + lane;
#pragma unroll
        for (int j = 0; j < 4; ++j) y[r][j] = xr[64 * j]; }
#pragma unroll
    for (int r = 0; r < NR; ++r) { float s = 0.f;
#pragma unroll
        for (int j = 0; j < 4; ++j) s += (y[r][j].x + y[r][j].y) + (y[r][j].z + y[r][j].w);
        const float mean = wave_sum(s, lane) * (1.f / DM); float s2 = 0.f;
#pragma unroll
        for (int j = 0; j < 4; ++j) { y[r][j] = y[r][j] - mean; s2 += (y[r][j].x * y[r][j].x + y[r][j].y * y[r][j].y) + (y[r][j].z * y[r][j].z + y[r][j].w * y[r][j].w); }
        const float rstd = 1.f / sqrtf(wave_sum(s2, lane) * (1.f / DM) + LN_EPS);
#pragma unroll
        for (int j = 0; j < 4; ++j) y[r][j] = y[r][j] * rstd * gm[j] + bt[j]; }
}
template <bool WF32, bool WBF>
__device__ __forceinline__ void ln_phase(const Frame& F0, const float* src, const float* gam, const float* bet, float* of, bf16* ob, unsigned char* o8, float* rs) {
    Frame F = F0; F.wave = opqs(F0.wave); F.vcu = opqs(F0.vcu); F.G = opqs(F0.G); F.lane = cur_lane(); F.tid = F.wave * 64 + F.lane;
    f32x4 gm[4], bt[4];
#pragma unroll
    for (int j = 0; j < 4; ++j) { gm[j] = ((const f32x4*)gam)[F.lane + 64 * j]; bt[j] = ((const f32x4*)bet)[F.lane + 64 * j]; }
    const int gw = F.vcu * NWAVES + F.wave, NGW = F.G * NWAVES;
    for (int m = gw * 4; m < T; m += NGW * 4) { f32x4 y[4][4]; ln_rows<4>(src + (size_t)m * DM, gm, bt, F.lane, y);
#pragma unroll
        for (int r = 0; r < 4; ++r) { store_row<WF32, WBF>(y[r], of + (size_t)(m + r) * DM, ob + (size_t)(m + r) * DM, F.lane); store_row_q8(y[r], o8 + (size_t)(m + r) * DM, rs + m + r, F.lane); } }
}

#define LNB_IDX(j, hh, lane) (512 * (j) + 8 * (lane) + 4 * (hh))
__device__ __forceinline__ void load_gb_bf(const float* gam, const float* bet, int lane, f32x4 (&gm)[4], f32x4 (&bt)[4]) {
#pragma unroll
    for (int j = 0; j < 2; ++j)
#pragma unroll
        for (int hh = 0; hh < 2; ++hh) { gm[2 * j + hh] = *(const f32x4*)(gam + LNB_IDX(j, hh, lane)); bt[2 * j + hh] = *(const f32x4*)(bet + LNB_IDX(j, hh, lane)); }
}
template <int NR>
__device__ __forceinline__ void ln_rows_bf(const bf16* src, const f32x4 (&gm)[4], const f32x4 (&bt)[4], int lane, f32x4 (&y)[NR][4]) {
    u32x4 raw[NR][2];
#pragma unroll
    for (int r = 0; r < NR; ++r)
#pragma unroll
        for (int j = 0; j < 2; ++j) raw[r][j] = *(const u32x4*)(src + (size_t)r * DM + 512 * j + 8 * lane);
#pragma unroll
    for (int r = 0; r < NR; ++r) { float s = 0.f;
#pragma unroll
        for (int j = 0; j < 2; ++j) { const u32x4 w = raw[r][j]; y[r][2 * j] = (f32x4){bf_lo(w.x), bf_hi(w.x), bf_lo(w.y), bf_hi(w.y)}; y[r][2 * j + 1] = (f32x4){bf_lo(w.z), bf_hi(w.z), bf_lo(w.w), bf_hi(w.w)}; }
#pragma unroll
        for (int j = 0; j < 4; ++j) s += (y[r][j].x + y[r][j].y) + (y[r][j].z + y[r][j].w);
        const float mean = wave_sum(s, lane) * (1.f / DM); float s2 = 0.f;
#pragma unroll
        for (int j = 0; j < 4; ++j) { y[r][j] = y[r][j] - mean; s2 += (y[r][j].x * y[r][j].x + y[r][j].y * y[r][j].y) + (y[r][j].z * y[r][j].z + y[r][j].w * y[r][j].w); }
        const float rstd = 1.f / sqrtf(wave_sum(s2, lane) * (1.f / DM) + LN_EPS);
#pragma unroll
        for (int j = 0; j < 4; ++j) y[r][j] = y[r][j] * rstd * gm[j] + bt[j]; }
}
__device__ __forceinline__ void store_row_bf_q8(const f32x4 (&y)[4], unsigned char* o8, float* rsp, int lane, LAS float* rsl = nullptr) {
    float am = 0.f;
#pragma unroll
    for (int j = 0; j < 4; ++j) am = fmaxf(fmaxf(am, fmaxf(fabsf(y[j].x), fabsf(y[j].y))), fmaxf(fabsf(y[j].z), fabsf(y[j].w)));
    am = fmaxf(wave_max(am), 1e-20f); const float inv = 127.f / am;
#pragma unroll
    for (int j = 0; j < 2; ++j) { u32x2 w; w.x = pack4_i8(q8(y[2 * j].x * inv), q8(y[2 * j].y * inv), q8(y[2 * j].z * inv), q8(y[2 * j].w * inv)); w.y = pack4_i8(q8(y[2 * j + 1].x * inv), q8(y[2 * j + 1].y * inv), q8(y[2 * j + 1].z * inv), q8(y[2 * j + 1].w * inv));
        *(u32x2*)(o8 + 512 * j + 8 * lane) = w; }
    if (lane == 0) { if (rsl) *rsl = am * (1.f / 127.f); else *rsp = am * (1.f / 127.f); }
}
template <bool WF32, bool WBF>
__device__ __forceinline__ void store_row_bf(const f32x4 (&y)[4], float* of, bf16* ob, int lane) {
#pragma unroll
    for (int j = 0; j < 2; ++j) {
        if (WF32) { *(f32x4*)(of + 512 * j + 8 * lane) = y[2 * j]; *(f32x4*)(of + 512 * j + 8 * lane + 4) = y[2 * j + 1]; }
        if (WBF) { u32x4 w; w.x = cvt_pk_bf16(y[2 * j].x, y[2 * j].y); w.y = cvt_pk_bf16(y[2 * j].z, y[2 * j].w); w.z = cvt_pk_bf16(y[2 * j + 1].x, y[2 * j + 1].y); w.w = cvt_pk_bf16(y[2 * j + 1].z, y[2 * j + 1].w);
            *(u32x4*)(ob + 512 * j + 8 * lane) = w; } }
}
template <bool WF32, bool WBF>
__device__ __forceinline__ void ln_phase_bf(const Frame& F0, const bf16* src, const float* gam, const float* bet, float* of, bf16* ob, unsigned char* o8, float* rs) {
    Frame F = F0; F.wave = opqs(F0.wave); F.vcu = opqs(F0.vcu); F.G = opqs(F0.G); F.lane = cur_lane(); F.tid = F.wave * 64 + F.lane;
    f32x4 gm[4], bt[4]; load_gb_bf(gam, bet, F.lane, gm, bt);
    const int gw = F.vcu * NWAVES + F.wave, NGW = F.G * NWAVES;
    for (int m = gw * 8; m < T; m += NGW * 8) { f32x4 y[8][4]; ln_rows_bf<8>(src + (size_t)m * DM, gm, bt, F.lane, y);
#pragma unroll
        for (int r = 0; r < 8; ++r) { store_row_bf<WF32, WBF>(y[r], of + (size_t)(m + r) * DM, ob + (size_t)(m + r) * DM, F.lane); if (WBF) store_row_bf_q8(y[r], o8 + (size_t)(m + r) * DM, rs + m + r, F.lane); } }
}

__device__ __forceinline__ void ln_router_phase(const Frame& F0, const bf16* src, bf16* hb, unsigned char* hb8, const float* gam, const float* bet, const float* w_router, const float* rbias, int* perm, float* dwp, gu32* gcnt) {
    Frame F = F0; F.wave = opqs(F0.wave); F.vcu = opqs(F0.vcu); F.G = opqs(F0.G); F.lane = cur_lane(); F.tid = F.wave * 64 + F.lane;
    constexpr int ATS = 1028;
    LAS float* AT = (LAS float*)F.lds;
    LAS float* PART = (LAS float*)(F.lds + 65792);
    LAS float* LOG = (LAS float*)(F.lds + 73984);
    LAS int* lcnt = (LAS int*)(F.lds + 90368);
    LAS int* lbase = (LAS int*)(F.lds + 90368 + 128);
    LAS int* rinfo = (LAS int*)(F.lds + 90368 + 256);
    LAS f32x4* dwl = (LAS f32x4*)(F.lds + 90368 + 2048);
    LAS float* rsl = (LAS float*)(F.lds + 90368 + 8192);
    const int RPB = T / F.G, NT = RPB / 16, row0 = F.vcu * RPB;
    if (F.tid < NBK) lcnt[F.tid] = 0;
    f32x4 gm[4], bt[4]; load_gb_bf(gam, bet, F.lane, gm, bt);
    const int mr = F.lane & 15, kq = F.lane >> 4;
    float wreg[32];
#pragma unroll
    for (int s = 0; s < 32; ++s) wreg[s] = w_router[(size_t)(128 * F.wave + 32 * kq + s) * 16 + mr];
    u32x4 raw[2][2];
#pragma unroll
    for (int r = 0; r < 2; ++r)
#pragma unroll
        for (int j = 0; j < 2; ++j) raw[r][j] = *(const u32x4*)(src + (size_t)(row0 + F.wave * 2 + r) * DM + 512 * j + 8 * F.lane);
    for (int t = 0; t < NT; ++t) {
        f32x4 y[2][4];
#pragma unroll
        for (int r = 0; r < 2; ++r) { float sm = 0.f;
#pragma unroll
            for (int j = 0; j < 2; ++j) { const u32x4 w = raw[r][j]; y[r][2 * j] = (f32x4){bf_lo(w.x), bf_hi(w.x), bf_lo(w.y), bf_hi(w.y)}; y[r][2 * j + 1] = (f32x4){bf_lo(w.z), bf_hi(w.z), bf_lo(w.w), bf_hi(w.w)}; }
#pragma unroll
            for (int j = 0; j < 4; ++j) sm += (y[r][j].x + y[r][j].y) + (y[r][j].z + y[r][j].w);
            const float mean = wave_sum(sm, F.lane) * (1.f / DM); float s2 = 0.f;
#pragma unroll
            for (int j = 0; j < 4; ++j) { y[r][j] = y[r][j] - mean; s2 += (y[r][j].x * y[r][j].x + y[r][j].y * y[r][j].y) + (y[r][j].z * y[r][j].z + y[r][j].w * y[r][j].w); }
            const float rstd = 1.f / sqrtf(wave_sum(s2, F.lane) * (1.f / DM) + LN_EPS);
#pragma unroll
            for (int j = 0; j < 4; ++j) y[r][j] = y[r][j] * rstd * gm[j] + bt[j]; }
        if (t + 1 < NT) {
#pragma unroll
            for (int r = 0; r < 2; ++r)
#pragma unroll
                for (int j = 0; j < 2; ++j) raw[r][j] = *(const u32x4*)(src + (size_t)(row0 + (t + 1) * 16 + F.wave * 2 + r) * DM + 512 * j + 8 * F.lane);
        }
#pragma unroll
        for (int r = 0; r < 2; ++r) { const int lr = F.wave * 2 + r; store_row_bf<false, true>(y[r], (float*)nullptr, hb + (size_t)(row0 + t * 16 + lr) * DM, F.lane);
            store_row_bf_q8(y[r], hb8 + (size_t)(row0 + t * 16 + lr) * DM, (float*)nullptr, F.lane, rsl + t * 16 + lr);
#pragma unroll
            for (int j = 0; j < 2; ++j) { *(LAS f32x4*)(AT + lr * ATS + 512 * j + 8 * F.lane) = y[r][2 * j]; *(LAS f32x4*)(AT + lr * ATS + 512 * j + 8 * F.lane + 4) = y[r][2 * j + 1]; } }
        __syncthreads();
        f32x4 acc = (f32x4){0.f, 0.f, 0.f, 0.f};
        { const LAS float* ap = AT + mr * ATS + 128 * F.wave + 32 * kq; f32x4 av[8];
#pragma unroll
          for (int q = 0; q < 8; ++q) av[q] = *(const LAS f32x4*)(ap + 4 * q);
#pragma unroll
          for (int q = 0; q < 8; ++q) { acc = __builtin_amdgcn_mfma_f32_16x16x4f32(av[q].x, wreg[4 * q], acc, 0, 0, 0); acc = __builtin_amdgcn_mfma_f32_16x16x4f32(av[q].y, wreg[4 * q + 1], acc, 0, 0, 0);
              acc = __builtin_amdgcn_mfma_f32_16x16x4f32(av[q].z, wreg[4 * q + 2], acc, 0, 0, 0); acc = __builtin_amdgcn_mfma_f32_16x16x4f32(av[q].w, wreg[4 * q + 3], acc, 0, 0, 0); } }
#pragma unroll
        for (int i = 0; i < 4; ++i) PART[(F.wave * 16 + 4 * kq + i) * 16 + mr] = acc[i];
        __syncthreads();
        if (F.tid < 256) { float sacc = 0.f;
#pragma unroll
            for (int w8 = 0; w8 < 8; ++w8) sacc += PART[w8 * 256 + F.tid];
            LOG[(t * 16 + (F.tid >> 4)) * 16 + (F.tid & 15)] = sacc; }
    }
    __syncthreads();
    float rb[16];
#pragma unroll
    for (int e = 0; e < 16; ++e) rb[e] = rbias[e];
    if (F.tid < RPB) {
        const int m = row0 + F.tid;
        float sc[16], sel[16];
#pragma unroll
        for (int q = 0; q < 4; ++q) { const f32x4 lg = *(const LAS f32x4*)(LOG + F.tid * 16 + 4 * q);
            sc[4 * q] = 1.f / (1.f + __expf(-lg.x)); sc[4 * q + 1] = 1.f / (1.f + __expf(-lg.y)); sc[4 * q + 2] = 1.f / (1.f + __expf(-lg.z)); sc[4 * q + 3] = 1.f / (1.f + __expf(-lg.w)); }
#pragma unroll
        for (int e = 0; e < 16; ++e) sel[e] = sc[e] + rb[e];
        float gs[4];
#pragma unroll
        for (int g = 0; g < 4; ++g) { const float a = sel[4 * g], b = sel[4 * g + 1], c = sel[4 * g + 2], d = sel[4 * g + 3];
            const float h1 = fmaxf(a, b), l1 = fminf(a, b), h2 = fmaxf(c, d), l2 = fminf(c, d); gs[g] = fmaxf(h1, h2) + fmaxf(fminf(h1, h2), fmaxf(l1, l2)); }
        int bg = 0; float bs = gs[0];
#pragma unroll
        for (int g = 1; g < 4; ++g) if (gs[g] > bs) { bs = gs[g]; bg = g; }
        float v[4], s4[4];
#pragma unroll
        for (int j = 0; j < 4; ++j) { v[j] = bg == 0 ? sel[j] : bg == 1 ? sel[4 + j] : bg == 2 ? sel[8 + j] : sel[12 + j]; s4[j] = bg == 0 ? sc[j] : bg == 1 ? sc[4 + j] : bg == 2 ? sc[8 + j] : sc[12 + j]; }
        int i1 = 0; float m1 = v[0];
#pragma unroll
        for (int j = 1; j < 4; ++j) if (v[j] > m1) { m1 = v[j]; i1 = j; }
        int i2 = -1; float m2 = -3.0e38f;
#pragma unroll
        for (int j = 0; j < 4; ++j) if (j != i1 && v[j] > m2) { m2 = v[j]; i2 = j; }
        const float s1 = i1 == 0 ? s4[0] : i1 == 1 ? s4[1] : i1 == 2 ? s4[2] : s4[3], s2 = i2 == 0 ? s4[0] : i2 == 1 ? s4[1] : i2 == 2 ? s4[2] : s4[3];
        const float inv = 1.f / (s1 + s2), w1 = s1 * inv, w2 = s2 * inv;
        const int lo = i1 < i2 ? i1 : i2, hi = i1 < i2 ? i2 : i1, bk = bg * 6 + (lo == 0 ? hi - 1 : lo == 1 ? hi + 1 : 5);
        const f32x2 dw = (f32x2){i1 < i2 ? w1 : w2, i1 < i2 ? w2 : w1};
        const int rank = atomicAdd((int*)&lcnt[bk], 1); rinfo[F.tid] = m | (bk << 16) | (rank << 21); dwl[F.tid] = (f32x4){dw.x, dw.y, rsl[F.tid], 0.f};
    }
    __syncthreads();
    if (F.tid < NBK) lbase[F.tid] = (int)__hip_atomic_fetch_add(gcnt + F.tid, (unsigned)lcnt[F.tid], RLX_AGENT);
    __syncthreads();
    if (F.tid < RPB) { const int info = rinfo[F.tid]; const int tok = info & 0xffff, bk = (info >> 16) & 31, rank = info >> 21; const size_t slot = (size_t)bk * T + lbase[bk] + rank;
        perm[slot] = tok; ((f32x4*)dwp)[slot] = dwl[F.tid]; }
    __syncthreads();
}

__device__ __forceinline__ void conv_phase(const Frame& F0, const bf16* PA, const float* cw, bf16* Y0) {
    Frame F = F0; F.wave = opqs(F0.wave); F.vcu = opqs(F0.vcu); F.G = opqs(F0.G); F.lane = cur_lane(); F.tid = F.wave * 64 + F.lane;
    for (int rr = F.vcu * NTHREADS + F.tid; rr < (T / 8) * 32; rr += F.G * NTHREADS) {
        const int co = rr & 31, run = rr >> 5, t0 = run * 8, c0 = co * 8;
        float w[3][8];
#pragma unroll
        for (int j = 0; j < 3; ++j) { const f32x4 a = *(const f32x4*)(cw + j * 256 + c0), b = *(const f32x4*)(cw + j * 256 + c0 + 4); w[j][0] = a.x; w[j][1] = a.y; w[j][2] = a.z; w[j][3] = a.w; w[j][4] = b.x; w[j][5] = b.y; w[j][6] = b.z; w[j][7] = b.w; }
        float u1[8], u2[8];
        const bool first = (t0 % SEQ) == 0;
#pragma unroll
        for (int q = 0; q < 8; ++q) { u1[q] = 0.f; u2[q] = 0.f; }
        if (!first) {
            const u32x4 h1 = *(const u32x4*)(PA + (size_t)(t0 - 1) * 768 + c0), g1 = *(const u32x4*)(PA + (size_t)(t0 - 1) * 768 + 512 + c0);
            const u32x4 h2 = *(const u32x4*)(PA + (size_t)(t0 - 2) * 768 + c0), g2 = *(const u32x4*)(PA + (size_t)(t0 - 2) * 768 + 512 + c0);
#pragma unroll
            for (int q = 0; q < 4; ++q) { u1[2 * q] = bf_lo(h1[q]) * bf_lo(g1[q]); u1[2 * q + 1] = bf_hi(h1[q]) * bf_hi(g1[q]); u2[2 * q] = bf_lo(h2[q]) * bf_lo(g2[q]); u2[2 * q + 1] = bf_hi(h2[q]) * bf_hi(g2[q]); }
        }
#pragma unroll
        for (int i = 0; i < 8; ++i) { const bf16* row = PA + (size_t)(t0 + i) * 768 + c0;
            const u32x4 hh = *(const u32x4*)row, bb = *(const u32x4*)(row + 256), cc = *(const u32x4*)(row + 512);
            float u0[8], yv[8];
#pragma unroll
            for (int q = 0; q < 4; ++q) { u0[2 * q] = bf_lo(hh[q]) * bf_lo(cc[q]); u0[2 * q + 1] = bf_hi(hh[q]) * bf_hi(cc[q]); }
#pragma unroll
            for (int q = 0; q < 8; ++q) { const float bgv = (q & 1) ? bf_hi(bb[q >> 1]) : bf_lo(bb[q >> 1]); yv[q] = bgv * (w[0][q] * u2[q] + w[1][q] * u1[q] + w[2][q] * u0[q]); u2[q] = u1[q]; u1[q] = u0[q]; }
            u32x4 o; o.x = cvt_pk_bf16(yv[0], yv[1]); o.y = cvt_pk_bf16(yv[2], yv[3]); o.z = cvt_pk_bf16(yv[4], yv[5]); o.w = cvt_pk_bf16(yv[6], yv[7]);
            *(u32x4*)(Y0 + (size_t)(t0 + i) * 256 + c0) = o; }
    }
}

__device__ __forceinline__ void attn_unit(const bf16* Q, const bf16* Kb, const bf16* VT, bf16* Y1, int b, int hd, int qt, int lane) {
    const int r = lane & 31, h = lane >> 5;
    const size_t tokb = (size_t)b * SEQ;
    bf16x8 qf[4];
    { const bf16* qp = Q + (tokb + qt * 32 + r) * 256 + hd * 64 + 8 * h;
#pragma unroll
      for (int s = 0; s < 4; ++s) qf[s] = *(const bf16x8*)(qp + 16 * s); }
    f32x16 o0, o1;
#pragma unroll
    for (int i = 0; i < 16; ++i) { o0[i] = 0.f; o1[i] = 0.f; }
    float R = 1.f;
    bf16x8 kf[4], vf[2][2], kn[4], vn[2][2];
#define AT_LOAD(KF, VF, kt_) do { const bf16* kp = Kb + (tokb + (kt_) * 32 + r) * 256 + hd * 64 + 8 * h; \
        _Pragma("unroll") for (int s = 0; s < 4; ++s) KF[s] = *(const bf16x8*)(kp + 16 * s); \
        _Pragma("unroll") for (int db = 0; db < 2; ++db) _Pragma("unroll") for (int s = 0; s < 2; ++s) { const bf16* vp = VT + (((size_t)hd * (T / 32) + (size_t)b * (SEQ / 32) + (kt_)) * 64 + db * 32 + r) * 32 + 16 * s + 4 * h; \
            const u32x2 lo = *(const u32x2*)vp, hi = *(const u32x2*)(vp + 8); const u32x4 w = (u32x4){lo.x, lo.y, hi.x, hi.y}; VF[db][s] = __builtin_bit_cast(bf16x8, w); } } while (0)
    AT_LOAD(kf, vf, qt);
#define AT_TILE(DG, kt_) do { { const int ktn = (kt_) > 0 ? (kt_) - 1 : 0; AT_LOAD(kn, vn, ktn); } \
        f32x16 st; _Pragma("unroll") for (int i = 0; i < 16; ++i) st[i] = 0.f; \
        _Pragma("unroll") for (int s = 0; s < 4; ++s) st = __builtin_amdgcn_mfma_f32_32x32x16_bf16(kf[s], qf[s], st, 0, 0, 0); \
        float nb[16], bt_[16]; \
        _Pragma("unroll") for (int i = 0; i < 16; ++i) { const float e2 = __builtin_amdgcn_exp2f(-fmaxf(st[i], -120.f)); const float rr = __builtin_amdgcn_rcpf(1.f + e2), er = e2 * rr; \
            if (DG) { const int kidx = (i & 3) + 8 * (i >> 2) + 4 * h; const bool valid = kidx < r; nb[i] = valid ? er : 1.f; bt_[i] = valid ? rr : 0.f; } else { nb[i] = er; bt_[i] = rr; } } \
        float Gs[4], Go[4]; \
        _Pragma("unroll") for (int g = 0; g < 4; ++g) { Gs[g] = (nb[4 * g] * nb[4 * g + 1]) * (nb[4 * g + 2] * nb[4 * g + 3]); Go[g] = shfl_xor_l(Gs[g], 32, lane); } \
        float tail[4]; tail[3] = 1.f; tail[2] = Gs[3] * Go[3]; tail[1] = tail[2] * (Gs[2] * Go[2]); tail[0] = tail[1] * (Gs[1] * Go[1]); \
        const float total = tail[0] * (Gs[0] * Go[0]); \
        float p[16]; \
        _Pragma("unroll") for (int g = 0; g < 4; ++g) { const float base = R * tail[g] * (h == 0 ? Go[g] : 1.f); \
            const float w3 = base, w2 = w3 * nb[4 * g + 3], w1 = w2 * nb[4 * g + 2], w0 = w1 * nb[4 * g + 1]; \
            p[4 * g + 3] = bt_[4 * g + 3] * w3; p[4 * g + 2] = bt_[4 * g + 2] * w2; p[4 * g + 1] = bt_[4 * g + 1] * w1; p[4 * g] = bt_[4 * g] * w0; } \
        R *= total; \
        bf16x8 pf[2]; \
        _Pragma("unroll") for (int s = 0; s < 2; ++s) { u32x4 w; w.x = cvt_pk_bf16(p[8 * s], p[8 * s + 1]); w.y = cvt_pk_bf16(p[8 * s + 2], p[8 * s + 3]); w.z = cvt_pk_bf16(p[8 * s + 4], p[8 * s + 5]); w.w = cvt_pk_bf16(p[8 * s + 6], p[8 * s + 7]); pf[s] = __builtin_bit_cast(bf16x8, w); } \
        _Pragma("unroll") for (int s = 0; s < 2; ++s) { o0 = __builtin_amdgcn_mfma_f32_32x32x16_bf16(vf[0][s], pf[s], o0, 0, 0, 0); o1 = __builtin_amdgcn_mfma_f32_32x32x16_bf16(vf[1][s], pf[s], o1, 0, 0, 0); } \
        _Pragma("unroll") for (int s = 0; s < 4; ++s) kf[s] = kn[s]; \
        _Pragma("unroll") for (int db = 0; db < 2; ++db) _Pragma("unroll") for (int s = 0; s < 2; ++s) vf[db][s] = vn[db][s]; } while (0)
    AT_TILE(true, qt);
    for (int kt = qt - 1; kt >= 0; --kt) {
        if (__all(R < 5.9605e-8f)) break;
        AT_TILE(false, kt);
    }
#undef AT_TILE
#undef AT_LOAD
    bf16* yp = Y1 + (tokb + qt * 32 + r) * 256 + hd * 64 + 4 * h;
#pragma unroll
    for (int g = 0; g < 4; ++g) { u32x2 w; w.x = cvt_pk_bf16(o0[4 * g], o0[4 * g + 1]); w.y = cvt_pk_bf16(o0[4 * g + 2], o0[4 * g + 3]); *(u32x2*)(yp + 8 * g) = w;
        u32x2 w1; w1.x = cvt_pk_bf16(o1[4 * g], o1[4 * g + 1]); w1.y = cvt_pk_bf16(o1[4 * g + 2], o1[4 * g + 3]); *(u32x2*)(yp + 32 + 8 * g) = w1; }
}
__device__ __forceinline__ void attn_phase(const Frame& F0, const bf16* Q, const bf16* Kb, const bf16* VT, bf16* Y1) {
    Frame F = F0; F.wave = opqs(F0.wave); F.vcu = opqs(F0.vcu); F.G = opqs(F0.G); F.lane = cur_lane(); F.tid = F.wave * 64 + F.lane;
    const int gw = F.vcu * NWAVES + F.wave, NGW = F.G * NWAVES;
    for (int u = gw; u < (T / 32) * 4; u += NGW) { const int hd = u >> 10, tt = u & 1023, b = tt >> 9, qt = tt & 511; attn_unit(Q, Kb, VT, Y1, b, hd, qt, F.lane); }
}

constexpr int VTP = 144;
__device__ __forceinline__ void gmlp_phase(const Frame& F0, const bf16* UC, const bf16* SGW, const float* sgb, const float* lng, const float* lnb, bf16* Y2) {
    Frame F = F0; F.wave = opqs(F0.wave); F.vcu = opqs(F0.vcu); F.G = opqs(F0.G); F.lane = cur_lane(); F.tid = F.wave * 64 + F.lane;
    LAS bf16* VTl = (LAS bf16*)F.lds;
    const int lane = F.lane, w = F.wave, r = lane & 31, h = lane >> 5;
    const f32x4 g4 = ((const f32x4*)lng)[lane], b4 = ((const f32x4*)lnb)[lane];
    for (int ch = F.vcu; ch < T / 128; ch += F.G) {
        const size_t tok0 = (size_t)ch * 128;
        bf16x8 wfr[8][2];
        { const int g_ = w >> 1, th_ = w & 1;
#pragma unroll
          for (int ks = 0; ks < 8; ++ks)
#pragma unroll
              for (int tb = 0; tb < 2; ++tb) wfr[ks][tb] = *(const bf16x8*)(SGW + ((size_t)g_ * 128 + 64 * th_ + 32 * tb + r) * 128 + 16 * ks + 8 * h); }
        u32x2 raw[16];
#pragma unroll
        for (int i = 0; i < 16; ++i) raw[i] = *(const u32x2*)(UC + (tok0 + w * 16 + i) * 512 + 256 + 4 * lane);
#pragma unroll
        for (int ip = 0; ip < 8; ++ip) { unsigned pk[2][2];
#pragma unroll
            for (int q = 0; q < 2; ++q) { const u32x2 rw = raw[2 * ip + q];
                float x0 = bf_lo(rw.x), x1 = bf_hi(rw.x), x2 = bf_lo(rw.y), x3 = bf_hi(rw.y);
                const float mean = wave_sum((x0 + x1) + (x2 + x3), lane) * (1.f / 256.f); x0 -= mean; x1 -= mean; x2 -= mean; x3 -= mean;
                const float rstd = 1.f / sqrtf(wave_sum((x0 * x0 + x1 * x1) + (x2 * x2 + x3 * x3), lane) * (1.f / 256.f) + LN_EPS);
                pk[q][0] = cvt_pk_bf16(x0 * rstd * g4.x + b4.x, x1 * rstd * g4.y + b4.y); pk[q][1] = cvt_pk_bf16(x2 * rstd * g4.z + b4.z, x3 * rstd * g4.w + b4.w); }
            const int s0 = ((((w * 2 + (ip >> 2)) ^ ((lane >> 2) & 15)) << 2) | (ip & 3));
            LAS unsigned* vt32 = (LAS unsigned*)VTl;
            vt32[(4 * lane + 0) * (VTP / 2) + s0] = (pk[0][0] & 0xffffu) | (pk[1][0] << 16); vt32[(4 * lane + 1) * (VTP / 2) + s0] = (pk[0][0] >> 16) | (pk[1][0] & 0xffff0000u);
            vt32[(4 * lane + 2) * (VTP / 2) + s0] = (pk[0][1] & 0xffffu) | (pk[1][1] << 16); vt32[(4 * lane + 3) * (VTP / 2) + s0] = (pk[0][1] >> 16) | (pk[1][1] & 0xffff0000u); }
        __syncthreads();
        const int g = w >> 1, th = w & 1;
        f32x16 acc[2][2];
#pragma unroll
        for (int a = 0; a < 2; ++a)
#pragma unroll
            for (int b = 0; b < 2; ++b)
#pragma unroll
                for (int i = 0; i < 16; ++i) acc[a][b][i] = 0.f;
        u32x2 uu[2][2][4];
#pragma unroll
        for (int tb = 0; tb < 2; ++tb)
#pragma unroll
            for (int cb = 0; cb < 2; ++cb)
#pragma unroll
                for (int q = 0; q < 4; ++q) uu[tb][cb][q] = *(const u32x2*)(UC + (tok0 + 64 * th + 32 * tb + r) * 512 + g * 64 + cb * 32 + 8 * q + 4 * h);
#pragma unroll
        for (int ks = 0; ks < 8; ++ks) {
            bf16x8 af[2];
#pragma unroll
            for (int cb = 0; cb < 2; ++cb) af[cb] = *(const LAS bf16x8*)(VTl + (g * 64 + cb * 32 + r) * VTP + (((2 * ks + h) ^ ((g * 4 + cb * 2 + (r >> 4)) & 15)) << 3));
#pragma unroll
            for (int cb = 0; cb < 2; ++cb)
#pragma unroll
                for (int tb = 0; tb < 2; ++tb) acc[cb][tb] = __builtin_amdgcn_mfma_f32_32x32x16_bf16(af[cb], wfr[ks][tb], acc[cb][tb], 0, 0, 0);
        }
#pragma unroll
        for (int tb = 0; tb < 2; ++tb) { const int t = 64 * th + 32 * tb + r; const float bias = sgb[g * 128 + t]; const size_t tok = tok0 + t;
#pragma unroll
            for (int cb = 0; cb < 2; ++cb)
#pragma unroll
                for (int q = 0; q < 4; ++q) { const int c0 = g * 64 + cb * 32 + 8 * q + 4 * h; const u32x2 u1 = uu[tb][cb][q];
                    u32x2 o; o.x = cvt_pk_bf16(bf_lo(u1.x) * (acc[cb][tb][4 * q] + bias), bf_hi(u1.x) * (acc[cb][tb][4 * q + 1] + bias));
                    o.y = cvt_pk_bf16(bf_lo(u1.y) * (acc[cb][tb][4 * q + 2] + bias), bf_hi(u1.y) * (acc[cb][tb][4 * q + 3] + bias));
                    *(u32x2*)(Y2 + tok * 256 + c0) = o; } }
        __syncthreads();
    }
}

template <class Tp> __device__ __forceinline__ Tp* karg(int idx) {
    int off = 8 * idx; asm volatile("" : "+s"(off));
    const __attribute__((address_space(4))) char* kp = (const __attribute__((address_space(4))) char*)__builtin_amdgcn_kernarg_segment_ptr();
    const unsigned long long v = *(const __attribute__((address_space(4))) unsigned long long*)(kp + off);
    return (Tp*)(GAS Tp*)v;
}
#define KIN(i) karg<const float>(i)
#define KOUT() karg<float>(21)
#define KWS() karg<unsigned char>(22)
struct Args { const float* in[21]; float* out; unsigned char* ws; int ph_lo, ph_hi; };
__global__ void __launch_bounds__(NTHREADS, 2) fwd(Args args) {
    extern __shared__ __attribute__((aligned(16))) unsigned char lds[];
    Frame F;
    F.lds = (LAS unsigned char*)lds;
    F.MISC = (volatile LAS unsigned*)(F.lds + MISC_OFF);
    F.wave = __builtin_amdgcn_readfirstlane((int)threadIdx.x >> 6); F.lane = 0; F.tid = 0;
    F.G = gridDim.x; F.bx = blockIdx.x; { const int bx = blockIdx.x; F.vcu = (F.G % 8 == 0) ? (bx % 8) * (F.G / 8) + bx / 8 : bx; }
    F.ctl = (gu32*)(KWS() + WS_CTL);
    for (int u = threadIdx.x; u < (LDS_BYTES - LDSCTL_OFF) / 4; u += NTHREADS) ((LAS unsigned*)(F.lds + LDSCTL_OFF))[u] = 0u;
    __syncthreads();
    for (int i = threadIdx.x; i < SIGT_N; i += NTHREADS) { const float x = -8.f + ((float)i + 0.5f) * (1.f / 128.f); ((LAS unsigned char*)(F.lds + SIGT_OFF))[i] = (unsigned char)(255.f / (1.f + __expf(-x)) + 0.5f); }
    __syncthreads();
    XcdBarrier bar = xcd_barrier_post((unsigned*)(F.ctl + CW_BAR), F.MISC + 8);
    const int lo = args.ph_lo, hi = args.ph_hi;
#define IN(k) (lo <= (k) && (k) < hi)
#define SEAM(k) do { if (IN(k) && IN((k) + 1)) for (int rb_ = 0; rb_ < REP_BAR; ++rb_) { XcdBarrier b2; b2.bar = (unsigned*)((gu32*)(KWS() + WS_CTL) + CW_BAR); b2.x = (unsigned)opqs((int)bar.x); b2.st = F.MISC + 8; xcd_barrier(b2, opqs(F.wave) == 0 && cur_lane() == 0); } } while (0)

    if (IN(0)) {
        for (int rep = 0; rep < REP_P0; ++rep) {
        for (int s_ = opqs(F.vcu); s_ < 144; s_ += opqs(F.G)) convert_strip_item(F, KWS(), 0, KIN(3), KIN(16), KIN(17), s_);
        convert_weights(F, KWS(), 0, KIN(3), KIN(10), KIN(11), KIN(16), KIN(17), KIN(18), KIN(6), 0, opqs(F.vcu) * NWAVES + opqs(F.wave), opqs(F.G) * NWAVES);
        ln_phase<false, true>(F, KIN(0), KIN(1), KIN(2), KOUT(), (bf16*)(KWS() + WS_HB), KWS() + WS_HB8, (float*)(KWS() + WS_RS)); }
        SEAM(0);
    }
    for (int l = 0; l < DEPTH; ++l) {
        const int p0 = 1 + 8 * l;
        if (IN(p0)) {
            { unsigned char* ws = KWS(); pg8::Gemm g{(bf16*)(ws + WS_HB8), (bf16*)(ws + WS_WG8), T, 7 * 256, DM / 2, 0}; ProjOrder S; S.init(T, 7 * 256, opqs(F.G), opqs(F.bx));
              EpiProj E{(bf16*)(ws + WS_PA), (bf16*)(ws + WS_Q), (bf16*)(ws + WS_K), (bf16*)(ws + WS_UC), (unsigned char*)(ws + WS_GATE), KIN(4) + (size_t)l * 3 * DM, (const LAS unsigned char*)(F.lds + SIGT_OFF), (const float*)(ws + WS_RS), (const float*)(ws + WS_CS)};
              pg8::gemm_phase<EpiProj, ProjOrder, true, false, false, true>(F.lds, opqs(F.wave), g, S, E); }
            { unsigned char* ws = KWS(); pg8::Gemm g{(bf16*)(ws + WS_WG8 + (size_t)1280 * DM), (bf16*)(ws + WS_HB8), 256, T, DM / 2, 0}; pg8::StaticOrder S; { const int G_ = opqs(F.G); S.init(256, T, G_, (opqs(F.bx) + G_ / 2) % G_); }
              EpiVt E{(bf16*)(ws + WS_VT), (const float*)(ws + WS_RS), (const float*)(ws + WS_CS)};
              pg8::gemm_phase<EpiVt, pg8::StaticOrder, true, false, false, true>(F.lds, opqs(F.wave), g, S, E); }
            { unsigned char* ws = KWS(); pg8::Gemm g{(bf16*)(ws + WS_HB8), (bf16*)(ws + WS_WG8 + (size_t)2048 * DM), T, 12 * 256, DM / 2, 0}; pg8::StaticOrder S; S.init(T, 12 * 256, opqs(F.G), opqs(F.bx));
              EpiGate E{(unsigned char*)(ws + WS_GATE), KIN(4) + (size_t)l * 3 * DM, (const float*)(ws + WS_RS), (const float*)(ws + WS_CS) + 2048, (const LAS unsigned char*)(F.lds + SIGT_OFF)};
              pg8::gemm_phase<EpiGate, pg8::StaticOrder, true, false, false, true>(F.lds, opqs(F.wave), g, S, E); }
            SEAM(p0);
        }
        if (IN(p0 + 1)) {
            for (int rep = 0; rep < REP_P2; ++rep) {
            if (l > 0) { convert_weights(F, KWS(), l, KIN(3), KIN(10), KIN(11), KIN(16), KIN(17), KIN(18), KIN(6), 2, opqs(F.vcu) * NWAVES + opqs(F.wave), opqs(F.G) * NWAVES); __syncthreads(); }
            for (int ra = 0; ra < REP_P2A; ++ra) { unsigned char* ws = KWS(); attn_phase(F, (bf16*)(ws + WS_Q), (bf16*)(ws + WS_K), (bf16*)(ws + WS_VT), (bf16*)(ws + WS_Y) + (size_t)T * 256); }
            for (int rb = 0; rb < REP_P2B; ++rb) { unsigned char* ws = KWS(); gmlp_phase(F, (bf16*)(ws + WS_UC), (bf16*)(ws + WS_SGW), KIN(7) + (size_t)l * 512, KIN(8) + (size_t)l * 256, KIN(9) + (size_t)l * 256, (bf16*)(ws + WS_Y) + (size_t)2 * T * 256); }
            for (int rc = 0; rc < REP_P2C; ++rc) { unsigned char* ws = KWS(); conv_phase(F, (bf16*)(ws + WS_PA), KIN(5) + (size_t)l * 768, (bf16*)(ws + WS_Y)); }
            }
            SEAM(p0 + 1);
        }
        if (IN(p0 + 2)) {
            for (int rep = 0; rep < REP_P3; ++rep) {
            unsigned char* ws = KWS(); pg8::Gemm g{(bf16*)(ws + WS_Y), (bf16*)(ws + WS_WBR), 3 * T, 3 * DM, 256}; MergeOrder S; S.S.init(T, DM, opqs(F.G), opqs(F.bx));
            EpiMerge E{(const unsigned char*)(ws + WS_GATE), (bf16*)(ws + WS_MG)};
            pg8::gemm_phase<EpiMerge, MergeOrder, true, false>(F.lds, opqs(F.wave), g, S, E); }
            SEAM(p0 + 2);
        }
        if (IN(p0 + 3)) {
            for (int rep = 0; rep < REP_P4; ++rep) {
            unsigned char* ws = KWS(); pg8::Gemm g{(bf16*)(ws + WS_MG), (bf16*)(ws + WS_WO), T, DM, DM}; pg8::StaticOrder S; S.init(T, DM, opqs(F.G), opqs(F.bx));
            EpiWo E{(bf16*)(ws + WS_HB), (bf16*)(ws + (rep + 1 < REP_P4 ? WS_PRE + 64 * MiB : WS_PRE))};
            pg8::gemm_phase<EpiWo, pg8::StaticOrder, true, false>(F.lds, opqs(F.wave), g, S, E); }
            SEAM(p0 + 3);
        }
        if (IN(p0 + 4)) {
            { unsigned char* ws = KWS();
            ln_router_phase(F, (bf16*)(ws + WS_PRE), (bf16*)(ws + WS_HB), ws + WS_HB8, KIN(12) + (size_t)l * DM, KIN(13) + (size_t)l * DM, KIN(14), KIN(15), (int*)(ws + WS_PERM), (float*)(ws + WS_DWP), (gu32*)(ws + WS_CTL) + CW_CNT + 64 * l); }
            SEAM(p0 + 4);
        }
        if (IN(p0 + 5)) {
            for (int rep = 0; rep < REP_P6; ++rep) {
            unsigned char* ws = KWS(); LAS int* mt = (LAS int*)(F.lds + MOE_OFF); moe_build(mt, (gu32*)(ws + WS_CTL) + CW_CNT + 64 * l, opqs(F.wave) * 64 + cur_lane());
            pg8::Gemm g{(bf16*)(ws + WS_HB8), (bf16*)(ws + WS_WU8), T, 4 * DM, DM / 2, 0}; MoeOrder<1> S{mt, opqs(F.G), opqs(F.bx), mtu(mt, 56), (int*)(ws + WS_PERM)};
            EpiMoeUp E{mt, (float*)(ws + WS_DWP), (bf16*)(ws + WS_PA), (const float*)(ws + WS_CSU)};
            pg8::gemm_phase<EpiMoeUp, MoeOrder<1>, true, true, false, true>(F.lds, opqs(F.wave), g, S, E);
            if (l + 1 < DEPTH && rep + 1 == REP_P6) {
                const int G_ = opqs(F.G), nfull = mtu(mt, 56) * 2 > G_ ? (mtu(mt, 56) * 2 - G_ < G_ ? mtu(mt, 56) * 2 - G_ : G_ - 1) : 0, c_ = opqs(F.bx);
                if (c_ >= nfull) for (int s_ = c_ - nfull; s_ < 80; s_ += G_ - nfull) convert_strip_item(F, KWS(), l + 1, KIN(3), KIN(16), KIN(17), s_);
                convert_weights(F, KWS(), l + 1, KIN(3), KIN(10), KIN(11), KIN(16), KIN(17), KIN(18), KIN(6), 1, c_ >= nfull ? (c_ - nfull) * NWAVES + opqs(F.wave) : -1, (G_ - nfull) * NWAVES); } }
            SEAM(p0 + 5);
        }
        if (IN(p0 + 6)) {
            for (int rep = 0; rep < REP_P7; ++rep) {
            unsigned char* ws = KWS(); LAS int* mt = (LAS int*)(F.lds + MOE_OFF); moe_build(mt, (gu32*)(ws + WS_CTL) + CW_CNT + 64 * l, opqs(F.wave) * 64 + cur_lane());
            pg8::Gemm g{(bf16*)(ws + WS_PA), (bf16*)(ws + WS_WD), T + NBK * 256, 4 * DM, 256, 128}; MoeOrder<2> S{mt, opqs(F.G), opqs(F.bx), mtu(mt, 56), (int*)(ws + WS_PERM)};
            EpiMoeDown E{mt, (int*)(ws + WS_PERM), (bf16*)(ws + WS_HB), (bf16*)(ws + (rep + 1 < REP_P7 ? WS_PRE + 64 * MiB : WS_PRE))};
            pg8::gemm_phase<EpiMoeDown, MoeOrder<2>, true, false, true>(F.lds, opqs(F.wave), g, S, E);
            if (l + 1 < DEPTH && rep + 1 == REP_P7) {
                const int G_ = opqs(F.G), nu_ = mtu(mt, 56) * 4, n3_ = nu_ > 2 * G_ ? (nu_ - 2 * G_ < G_ ? nu_ - 2 * G_ : G_ - 1) : 0, c_ = opqs(F.bx);
                if (c_ >= n3_) for (int s_ = 80 + c_ - n3_; s_ < 144; s_ += G_ - n3_) convert_strip_item(F, KWS(), l + 1, KIN(3), KIN(16), KIN(17), s_); } }
            SEAM(p0 + 6);
        }
        if (IN(p0 + 7)) {
            for (int rep = 0; rep < REP_P8; ++rep) { const bool dry = rep + 1 < REP_P8;
            { float* out = KOUT(); unsigned char* ws = KWS(); float* of = dry ? (float*)(ws + WS_PRE + 64 * MiB) : out; bf16* ob = (bf16*)(ws + (dry ? WS_PRE + 64 * MiB : WS_HB)); const bf16* pre = (const bf16*)(ws + WS_PRE);
              if (l + 1 < DEPTH) ln_phase_bf<false, true>(F, pre, KIN(19) + (size_t)l * DM, KIN(20) + (size_t)l * DM, of, ob, ws + WS_HB8, (float*)(ws + WS_RS)); else ln_phase_bf<true, false>(F, pre, KIN(19) + (size_t)l * DM, KIN(20) + (size_t)l * DM, of, ob, ws + WS_HB8, (float*)(ws + WS_RS)); } }
            SEAM(p0 + 7);
        }
    }
#undef IN
#undef SEAM
}

extern "C" void kernel_launch(void* const* d_in, const int* in_sizes, int n_in, void* d_out, int out_size, void* d_ws, size_t ws_size, hipStream_t stream) {
    static int grid = 0;
    if (grid == 0) {
        if (n_in != 21 || out_size != T * DM || ws_size < WS_END) { fprintf(stderr, "kernel_launch: unexpected shapes (n_in %d out %d ws %zu)\n", n_in, out_size, ws_size); grid = -1; return; }
        int dev = 0, cus = 0, per_cu = 0;
        if (hipGetDevice(&dev) != hipSuccess || hipDeviceGetAttribute(&cus, hipDeviceAttributeMultiprocessorCount, dev) != hipSuccess) { grid = -1; return; }
        if (hipFuncSetAttribute((const void*)fwd, hipFuncAttributeMaxDynamicSharedMemorySize, LDS_BYTES) != hipSuccess) { fprintf(stderr, "kernel_launch: hipFuncSetAttribute failed\n"); grid = -1; return; }
        if (hipOccupancyMaxActiveBlocksPerMultiprocessor(&per_cu, (const void*)fwd, NTHREADS, LDS_BYTES) != hipSuccess || per_cu < 1) fprintf(stderr, "kernel_launch: occupancy query says %d\n", per_cu);
        (void)hipGetLastError();
        if (cus < 256) { fprintf(stderr, "kernel_launch: this kernel is laid out for 256 resident workgroups (one per CU); the device reports %d CUs\n", cus); grid = -1; return; }
        grid = 256;
    }
    if (grid < 0) return;
    (void)hipMemsetAsync((char*)d_ws + WS_CTL, 0, CTL_ZERO_BYTES, stream);
    Args a{};
    for (int i = 0; i < 21; ++i) a.in[i] = (const float*)d_in[i];
    a.out = (float*)d_out; a.ws = (unsigned char*)d_ws;
#if MK_PER_PHASE
    for (int p = 0; p < NPH; ++p) { a.ph_lo = p; a.ph_hi = p + 1; hipLaunchKernelGGL(fwd, dim3(grid), dim3(NTHREADS), LDS_BYTES, stream, a); }
#else
    a.ph_lo = 0; a.ph_hi = NPH;
    hipLaunchKernelGGL(fwd, dim3(grid), dim3(NTHREADS), LDS_BYTES, stream, a);
#endif
}
```
